# Optimizing an MI355X kernel written in HIP

```python
import math
import jax, jax.numpy as jnp
from jax import lax
import numpy as np

D_MODEL = 1024
BATCH = 1
SEQ = 16384
DEPTH = 4

GRID_W = 64
CTX_LEN = 256
ROPE_DIM = 64
ROPE_BASE = 10000.0
EPS = 1e-6
HG_HEADS = 4
HG_DIM = 128
HG_W = HG_HEADS * HG_DIM
MLA_HEADS = 4
MLA_NOPE = 128
MLA_ROPE = ROPE_DIM
MLA_V = 128
MLA_Q_RANK = 384
MLA_KV_RANK = 256
DA_HEADS = 4
DA_DIM = ROPE_DIM
DA_V = 2 * DA_DIM
RT_HEADS = 4
RT_K = ROPE_DIM
RT_V = 128
MLP_HIDDEN = 4 * D_MODEL
CHUNK = 64
Q_BLOCK = 128
ADA_STD = 0.5
N_EVEN = (DEPTH + 1) // 2
N_ODD = DEPTH // 2
A_SPLITS = (HG_W, HG_W, HG_W, HG_W, HG_W, MLA_Q_RANK, MLA_KV_RANK, MLA_ROPE)
C_SPLITS = (DA_HEADS * 2 * DA_DIM, DA_HEADS * 2 * DA_DIM, DA_HEADS * DA_V,
            RT_HEADS * RT_K, RT_HEADS * RT_K, RT_HEADS * RT_V, RT_HEADS * RT_V)
A_IN = sum(A_SPLITS)
C_IN = sum(C_SPLITS)
MIX_W = HG_W + MLA_HEADS * MLA_V

kernel_name = "hybrid_hgrn2_mla_diffattn_retnet_dit"


def _split(p, sizes):
    return jnp.split(p, np.cumsum(sizes)[:-1].tolist(), axis=-1)


def _rms(x, w):
    xf = x.astype(jnp.float32)
    y = xf * lax.rsqrt(jnp.mean(xf * xf, axis=-1, keepdims=True) + EPS)
    return y.astype(x.dtype) * w


def _heads(a, h):
    return a.reshape(a.shape[0], a.shape[1], h, -1)


def _rope_tables(n, dim):
    rows = n // GRID_W
    row = jnp.repeat(jnp.arange(rows, dtype=jnp.float32), GRID_W)
    col = jnp.tile(jnp.arange(GRID_W, dtype=jnp.float32), rows)
    quarter = dim // 4
    inv_freq = ROPE_BASE ** (-jnp.arange(quarter, dtype=jnp.float32) / quarter)
    ang_r = row[:, None] * inv_freq
    ang_c = col[:, None] * inv_freq
    ang = jnp.concatenate([ang_r, ang_r, ang_c, ang_c], axis=-1)
    return jnp.cos(ang), jnp.sin(ang)


def _apply_rope(x, cos, sin):
    bshape = (1, x.shape[1]) + (1,) * (x.ndim - 3) + (x.shape[-1],)
    cs = cos.reshape(bshape).astype(x.dtype)
    sn = sin.reshape(bshape).astype(x.dtype)
    xr = x.reshape(x.shape[:-1] + (2, 2, x.shape[-1] // 4))
    rot = jnp.stack([-xr[..., 1, :], xr[..., 0, :]], axis=-2).reshape(x.shape)
    return x * cs + rot * sn


def _softmax_attend(q, k, v, scale):
    s = jnp.einsum('bqhd,bkhd->bhqk', q, k).astype(jnp.float32) * scale
    p = jax.nn.softmax(s, axis=-1).astype(v.dtype)
    return jnp.einsum('bhqk,bkhd->bqhd', p, v)


def _diff_attend(q, k, v, lam, scale):
    s = jnp.einsum('bqhcd,bkhcd->bhcqk', q, k).astype(jnp.float32) * scale
    p = jax.nn.softmax(s, axis=-1)
    a = (p[:, :, 0] - lam * p[:, :, 1]).astype(v.dtype)
    return jnp.einsum('bhqk,bkhd->bqhd', a, v)


def _sweep_queries(q, attend):
    b, n = q.shape[:2]
    qb = q.reshape((b, n // Q_BLOCK, Q_BLOCK) + q.shape[2:]).swapaxes(0, 1)
    out = lax.map(attend, qb)
    return out.swapaxes(0, 1).reshape((b, n) + out.shape[3:])


def _chunk_scan(q, k, v, logf, s0):
    b, t, h, _ = q.shape
    nc = t // CHUNK

    def to_chunks(a):
        return a.reshape(b, nc, CHUNK, h, a.shape[-1]).transpose(1, 0, 3, 2, 4)

    qc, kc, vc, gc = to_chunks(q), to_chunks(k), to_chunks(v), to_chunks(logf)
    mask = jnp.tril(jnp.ones((CHUNK, CHUNK), dtype=bool))[:, :, None]

    def step(s, inp):
        qi, ki, vi, gi = inp
        bcum = jnp.cumsum(gi.astype(jnp.float32), axis=2)
        diff = bcum[:, :, :, None, :] - bcum[:, :, None, :, :]
        dec = jnp.exp(jnp.where(mask, diff, -jnp.inf))
        a = jnp.sum(qi[:, :, :, None, :] * dec * ki[:, :, None, :, :], axis=-1)
        o = (jnp.einsum('bhts,bhsv->bhtv', a, vi)
             + jnp.einsum('bhtk,bhkv->bhtv', qi * jnp.exp(bcum), s))
        last = bcum[:, :, -1:, :]
        s_new = (jnp.exp(last[:, :, 0, :])[..., None] * s
                 + jnp.einsum('bhsk,bhsv->bhkv', ki * jnp.exp(last - bcum), vi))
        return s_new, o

    s_fin, oc = lax.scan(step, s0, (qc, kc, vc, gc))
    o = oc.transpose(1, 0, 3, 2, 4).reshape(b, t, h, -1)
    return o, s_fin


def _final_state(k, v, logf):
    bcum = jnp.cumsum(logf.astype(jnp.float32), axis=1)
    w = jnp.exp(bcum[:, -1:] - bcum)
    return jnp.einsum('bthk,bthv->bhkv', k * w, v)


def _bidir_recurrence(q_l, v_l, kg_l, q_c, v_c, kg_c, need_ctx):
    outs_l, outs_c = [], []
    for d in range(2):
        fl = (lambda a: a[:, ::-1]) if d == 1 else (lambda a: a)
        (k_l, g_l), (k_c, g_c) = kg_l[d], kg_c[d]
        if need_ctx:
            s0 = jnp.zeros((v_c.shape[0], v_c.shape[2], k_c.shape[-1], v_c.shape[-1]), jnp.float32)
            o_c, s_ctx = _chunk_scan(fl(q_c), fl(k_c), fl(v_c), fl(g_c), s0)
            outs_c.append(fl(o_c))
        else:
            s_ctx = _final_state(fl(k_c), fl(v_c), fl(g_c))
        o_l, _ = _chunk_scan(fl(q_l), fl(k_l), fl(v_l), fl(g_l), s_ctx)
        outs_l.append(fl(o_l))
    y_l = (outs_l[0] + outs_l[1]).astype(v_l.dtype)
    y_c = (outs_c[0] + outs_c[1]).astype(v_c.dtype) if need_ctx else None
    return y_l, y_c


def _hgrn2_gate(p_f, lb):
    z = p_f.astype(jnp.float32)
    logf = jnp.logaddexp(jnp.log(lb), jnp.log1p(-lb) + jax.nn.log_sigmoid(z))
    logf = _heads(logf, HG_HEADS)
    return (-jnp.expm1(logf)).astype(p_f.dtype), logf


def _even_mixer(h_l, h_c, cos, sin, lb, w_in, hg_norm, q_norm, kv_norm, w_uq, w_ukv,
                qk_q, qk_k, need_ctx):
    b, n, _ = h_l.shape
    m = h_c.shape[1]
    pl = _split(h_l @ w_in, A_SPLITS)
    pc = _split(h_c @ w_in, A_SPLITS)

    kg_l = tuple(_hgrn2_gate(pl[1 + d], lb[d]) for d in range(2))
    kg_c = tuple(_hgrn2_gate(pc[1 + d], lb[d]) for d in range(2))
    hq_l = _heads(jax.nn.silu(pl[0]), HG_HEADS)
    hq_c = _heads(jax.nn.silu(pc[0]), HG_HEADS) if need_ctx else None
    o_l, o_c = _bidir_recurrence(hq_l, _heads(pl[3], HG_HEADS), kg_l,
                                 hq_c, _heads(pc[3], HG_HEADS), kg_c, need_ctx)
    hg_l = _rms(o_l, hg_norm).reshape(b, n, HG_W) * jax.nn.silu(pl[4])

    def mla_kv(p):
        kv = _heads(_rms(p[6], kv_norm) @ w_ukv, MLA_HEADS)
        k_nope, v = kv[..., :MLA_NOPE], kv[..., MLA_NOPE:]
        k_rope = jnp.broadcast_to(p[7][:, :, None, :], k_nope.shape[:3] + (MLA_ROPE,))
        return _rms(jnp.concatenate([k_nope, k_rope], axis=-1), qk_k), v

    def mla_q(p):
        return _rms(_heads(_rms(p[5], q_norm) @ w_uq, MLA_HEADS), qk_q)

    def rope_tail(a):
        return jnp.concatenate([a[..., :MLA_NOPE], _apply_rope(a[..., MLA_NOPE:], cos, sin)], axis=-1)

    scale = (MLA_NOPE + MLA_ROPE) ** -0.5
    k_c, v_c = mla_kv(pc)
    k_l, v_l = mla_kv(pl)
    k_all = jnp.concatenate([k_c, rope_tail(k_l)], axis=1)
    v_all = jnp.concatenate([v_c, v_l], axis=1)
    a_l = _sweep_queries(rope_tail(mla_q(pl)), lambda qb: _softmax_attend(qb, k_all, v_all, scale))
    y_l = jnp.concatenate([hg_l, a_l.reshape(b, n, MLA_HEADS * MLA_V)], axis=-1)

    if need_ctx:
        hg_c = _rms(o_c, hg_norm).reshape(b, m, HG_W) * jax.nn.silu(pc[4])
        a_c = _softmax_attend(mla_q(pc), k_c, v_c, scale)
        y_c = jnp.concatenate([hg_c, a_c.reshape(b, m, MLA_HEADS * MLA_V)], axis=-1)
    else:
        y_c = None
    return y_l, y_c


def _odd_mixer(h_l, h_c, cos, sin, layer, w_in, lam, qk_q, qk_k, subln, rt_decay, rt_norm, need_ctx):
    b, n, _ = h_l.shape
    m = h_c.shape[1]
    pl = _split(h_l @ w_in, C_SPLITS)
    pc = _split(h_c @ w_in, C_SPLITS)

    lam_init = 0.8 - 0.6 * math.exp(-0.3 * layer)
    lf = lam.astype(jnp.float32)
    lam_full = jnp.exp(jnp.sum(lf[0] * lf[1])) - jnp.exp(jnp.sum(lf[2] * lf[3])) + lam_init

    def sub(a):
        return a.reshape(a.shape[0], a.shape[1], DA_HEADS, 2, DA_DIM)

    scale = DA_DIM ** -0.5
    dk_c = _rms(sub(pc[1]), qk_k)
    dv_c = _heads(pc[2], DA_HEADS)
    dk_l = _apply_rope(_rms(sub(pl[1]), qk_k), cos, sin)
    dq_l = _apply_rope(_rms(sub(pl[0]), qk_q), cos, sin)
    k_all = jnp.concatenate([dk_c, dk_l], axis=1)
    v_all = jnp.concatenate([dv_c, _heads(pl[2], DA_HEADS)], axis=1)
    d_l = _sweep_queries(dq_l, lambda qb: _diff_attend(qb, k_all, v_all, lam_full, scale))
    d_l = (_rms(d_l, subln) * (1.0 - lam_init)).reshape(b, n, DA_HEADS * DA_V)

    log_gamma = jax.nn.log_sigmoid(rt_decay.astype(jnp.float32))

    def rt_kg(k):
        shp = k.shape[:3] + (1,)
        return tuple((k, jnp.broadcast_to(log_gamma[d][:, None], shp)) for d in range(2))

    rq_l = _apply_rope(_heads(pl[3], RT_HEADS), cos, sin)
    rk_l = _apply_rope(_heads(pl[4], RT_HEADS) * RT_K ** -0.5, cos, sin)
    rk_c = _heads(pc[4], RT_HEADS) * RT_K ** -0.5
    rq_c = _heads(pc[3], RT_HEADS) if need_ctx else None
    r_l, r_c = _bidir_recurrence(rq_l, _heads(pl[5], RT_HEADS), rt_kg(rk_l),
                                 rq_c, _heads(pc[5], RT_HEADS), rt_kg(rk_c), need_ctx)
    r_l = _rms(r_l, rt_norm).reshape(b, n, RT_HEADS * RT_V) * jax.nn.silu(pl[6])
    y_l = jnp.concatenate([d_l, r_l], axis=-1)

    if need_ctx:
        d_c = _diff_attend(_rms(sub(pc[0]), qk_q), dk_c, dv_c, lam_full, scale)
        d_c = (_rms(d_c, subln) * (1.0 - lam_init)).reshape(b, m, DA_HEADS * DA_V)
        r_c = _rms(r_c, rt_norm).reshape(b, m, RT_HEADS * RT_V) * jax.nn.silu(pc[6])
        y_c = jnp.concatenate([d_c, r_c], axis=-1)
    else:
        y_c = None
    return y_l, y_c


def _mlp(h, w1, w2):
    return jnp.square(jax.nn.relu(h @ w1)) @ w2


def setup_inputs(seed: int = 0) -> dict:
    key = jax.random.key(seed)
    k = jax.random.split(key, 26)
    f32 = jnp.float32

    def nrm(kk, shape, std):
        return jax.random.normal(kk, shape, f32) * std

    def gain(kk, shape):
        return 1.0 + 0.02 * jax.random.normal(kk, shape, f32)

    rt_base = jnp.log(2.0 ** (5.0 + jnp.arange(RT_HEADS, dtype=f32)) - 1.0)
    return {
        "x": nrm(k[0], (BATCH, SEQ, D_MODEL), 1.0),
        "c": nrm(k[1], (BATCH, D_MODEL), 1.0),
        "ctx": nrm(k[2], (BATCH, CTX_LEN, D_MODEL), 1.0),
        "c_ctx": nrm(k[3], (D_MODEL,), 1.0),
        "ada_w": nrm(k[4], (DEPTH, D_MODEL, 6 * D_MODEL), ADA_STD * D_MODEL ** -0.5),
        "ada_b": nrm(k[5], (DEPTH, 6 * D_MODEL), 0.01),
        "norm_w": gain(k[6], (DEPTH, 2, D_MODEL)),
        "w_o": nrm(k[7], (DEPTH, MIX_W, D_MODEL), MIX_W ** -0.5),
        "mlp_w1": nrm(k[8], (DEPTH, D_MODEL, MLP_HIDDEN), D_MODEL ** -0.5),
        "mlp_w2": nrm(k[9], (DEPTH, MLP_HIDDEN, D_MODEL), MLP_HIDDEN ** -0.5),
        "a_w_in": nrm(k[10], (N_EVEN, D_MODEL, A_IN), D_MODEL ** -0.5),
        "hg_lb": nrm(k[11], (N_EVEN, 2, HG_W), 0.5),
        "hg_norm": gain(k[12], (N_EVEN, HG_DIM)),
        "mla_q_norm": gain(k[13], (N_EVEN, MLA_Q_RANK)),
        "mla_kv_norm": gain(k[14], (N_EVEN, MLA_KV_RANK)),
        "mla_w_uq": nrm(k[15], (N_EVEN, MLA_Q_RANK, MLA_HEADS * (MLA_NOPE + MLA_ROPE)), MLA_Q_RANK ** -0.5),
        "mla_w_ukv": nrm(k[16], (N_EVEN, MLA_KV_RANK, MLA_HEADS * (MLA_NOPE + MLA_V)), MLA_KV_RANK ** -0.5),
        "mla_qk_q": gain(k[17], (N_EVEN, MLA_NOPE + MLA_ROPE)),
        "mla_qk_k": gain(k[18], (N_EVEN, MLA_NOPE + MLA_ROPE)),
        "c_w_in": nrm(k[19], (N_ODD, D_MODEL, C_IN), D_MODEL ** -0.5),
        "da_lambda": nrm(k[20], (N_ODD, 4, DA_DIM), 0.1),
        "da_qk_q": gain(k[21], (N_ODD, DA_DIM)),
        "da_qk_k": gain(k[22], (N_ODD, DA_DIM)),
        "da_subln": gain(k[23], (N_ODD, DA_V)),
        "rt_decay": rt_base + nrm(k[24], (N_ODD, 2, RT_HEADS), 0.01),
        "rt_norm": gain(k[25], (N_ODD, RT_V)),
    }


def reference(x, c, ctx, c_ctx, ada_w, ada_b, norm_w, w_o, mlp_w1, mlp_w2,
              a_w_in, hg_lb, hg_norm, mla_q_norm, mla_kv_norm, mla_w_uq, mla_w_ukv, mla_qk_q, mla_qk_k,
              c_w_in, da_lambda, da_qk_q, da_qk_k, da_subln, rt_decay, rt_norm):
    n = x.shape[1]
    cos, sin = _rope_tables(n, ROPE_DIM)
    lb = jnp.cumsum(jax.nn.softmax(hg_lb.astype(jnp.float32), axis=0), axis=0)
    lb = lb - lb[:1]
    xc = ctx
    for l in range(DEPTH):
        last = l == DEPTH - 1
        mod_l = (jax.nn.silu(c) @ ada_w[l] + ada_b[l])[:, None, :]
        mod_c = jax.nn.silu(c_ctx) @ ada_w[l] + ada_b[l]
        sh1, sc1, g1, sh2, sc2, g2 = jnp.split(mod_l, 6, axis=-1)
        csh1, csc1, cg1, csh2, csc2, cg2 = jnp.split(mod_c, 6, axis=-1)
        h_l = _rms(x, norm_w[l, 0]) * (1 + sc1) + sh1
        h_c = _rms(xc, norm_w[l, 0]) * (1 + csc1) + csh1
        j = l // 2
        if l % 2 == 0:
            y_l, y_c = _even_mixer(h_l, h_c, cos, sin, lb[j], a_w_in[j], hg_norm[j], mla_q_norm[j],
                                   mla_kv_norm[j], mla_w_uq[j], mla_w_ukv[j], mla_qk_q[j], mla_qk_k[j],
                                   not last)
        else:
            y_l, y_c = _odd_mixer(h_l, h_c, cos, sin, l, c_w_in[j], da_lambda[j], da_qk_q[j], da_qk_k[j],
                                  da_subln[j], rt_decay[j], rt_norm[j], not last)
        x = x + g1 * (y_l @ w_o[l])
        x = x + g2 * _mlp(_rms(x, norm_w[l, 1]) * (1 + sc2) + sh2, mlp_w1[l], mlp_w2[l])
        if not last:
            xc = xc + cg1 * (y_c @ w_o[l])
            xc = xc + cg2 * _mlp(_rms(xc, norm_w[l, 1]) * (1 + csc2) + csh2, mlp_w1[l], mlp_w2[l])
    return x
```

```cpp
#include <hip/hip_runtime.h>
#include <hip/hip_cooperative_groups.h>
#include <cstdio>
#include <cstdint>
#include <cstring>
namespace cg = cooperative_groups;

#ifndef REP_ATT
#define REP_ATT 1
#endif
#ifndef REP_REC
#define REP_REC 1
#endif
#ifndef REP_GEMM
#define REP_GEMM 1
#endif
#ifndef REP_MISC
#define REP_MISC 1
#endif
#ifndef MK_CG_SYNC
#define MK_CG_SYNC 0
#endif

typedef unsigned short bf16_t;
typedef short bf16x8 __attribute__((ext_vector_type(8)));
typedef short s16x4 __attribute__((ext_vector_type(4)));
typedef float f32x2 __attribute__((ext_vector_type(2)));
typedef float f32x4 __attribute__((ext_vector_type(4)));
typedef float f32x16 __attribute__((ext_vector_type(16)));
typedef unsigned u32x2 __attribute__((ext_vector_type(2)));
typedef unsigned u32x4 __attribute__((ext_vector_type(4)));
#define LAS __attribute__((address_space(3)))

constexpr int T_TOK = 16640, NCTX = 256, DM = 1024;
constexpr float EPSN = 1e-6f;
constexpr int LSC = 260, NSC = 64;

constexpr size_t OFF_X = 0;
constexpr size_t SZ_X = (size_t)T_TOK * DM * 4;
constexpr size_t OFF_HB = OFF_X + SZ_X;
constexpr size_t SZ_HB = (size_t)T_TOK * DM * 2;
constexpr size_t OFF_Y = OFF_HB + SZ_HB;
constexpr size_t OFF_W = OFF_Y + SZ_HB;
constexpr size_t W_IN = 0, W_O = 6815744, W_1 = 8912896, W_2 = 17301504, W_UQ = 25690112, W_UKV = 26279936, SZ_W = 26804224;
constexpr size_t OFF_MOD = OFF_W + SZ_W;
constexpr size_t OFF_ROPE = OFF_MOD + 196608;
constexpr size_t OFF_LB = OFF_ROPE + 32768;
constexpr size_t OFF_SCAL = OFF_LB + 8192;
constexpr size_t OFF_BAR = OFF_SCAL + 256;
constexpr size_t OFF_PART = OFF_BAR + 16384;
constexpr size_t OFF_D = OFF_PART + 8388608;
constexpr size_t DE_QH = 0, DE_F = 34078720, DE_VH = 102236160, DE_G = 119275520, DE_CQ = 136314880, DE_S = 161873920, DE_DL = 195428352;
constexpr size_t DE_U = 0, DE_QA = 59637760, DE_KA = 85196800, DE_VA = 110755840;
constexpr size_t DO_DQK = 0, DO_DV = 34078720, DO_RQ = 51118080, DO_RK = 68157440, DO_RV = 85196800, DO_RG = 102236160, DO_OD = 119275520, DO_S = 153354240;
constexpr size_t SZ_D = 195690496;
constexpr size_t WS_NEED = OFF_D + SZ_D;

struct Params {
  const float *x, *c, *ctx, *c_ctx, *ada_w, *ada_b, *norm_w, *w_o, *mlp_w1, *mlp_w2;
  const float *a_w_in, *hg_lb, *hg_norm, *mla_q_norm, *mla_kv_norm, *mla_w_uq, *mla_w_ukv, *mla_qk_q, *mla_qk_k;
  const float *c_w_in, *da_lambda, *da_qk_q, *da_qk_k, *da_subln, *rt_decay, *rt_norm;
  float* out;
  char* ws;
};

__device__ __forceinline__ unsigned cvt_pk_bf16(float lo, float hi) { unsigned r; asm volatile("v_cvt_pk_bf16_f32 %0, %1, %2" : "=v"(r) : "v"(lo), "v"(hi)); return r; }
__device__ __forceinline__ int tid_() { int t = threadIdx.x; asm volatile("" : "+v"(t)); return t; }
typedef __bf16 bf16x2v_t __attribute__((ext_vector_type(2)));
__device__ __forceinline__ unsigned cvtb(float lo, float hi) { const f32x2 v = {lo, hi}; const bf16x2v_t r = __builtin_convertvector(v, bf16x2v_t); return __builtin_bit_cast(unsigned, r); }
__device__ __forceinline__ float bf2f(bf16_t b) { return __uint_as_float(((unsigned)b) << 16); }
__device__ __forceinline__ bf16_t f2bf(float f) { return (bf16_t)(cvt_pk_bf16(f, 0.f) & 0xffffu); }
__device__ __forceinline__ float sigmoidf_(float v) { return __builtin_amdgcn_rcpf(1.0f + __expf(-v)); }
__device__ __forceinline__ float siluf_(float v) { return v * sigmoidf_(v); }
__device__ __forceinline__ float wave_sum(float v) {
  int x = __float_as_int(v);
  v += __int_as_float(__builtin_amdgcn_update_dpp(0, x, 0xB1, 0xf, 0xf, true)); x = __float_as_int(v);
  v += __int_as_float(__builtin_amdgcn_update_dpp(0, x, 0x4E, 0xf, 0xf, true)); x = __float_as_int(v);
  v += __int_as_float(__builtin_amdgcn_update_dpp(0, x, 0x124, 0xf, 0xf, true)); x = __float_as_int(v);
  v += __int_as_float(__builtin_amdgcn_update_dpp(0, x, 0x128, 0xf, 0xf, true));
  { auto r = __builtin_amdgcn_permlane16_swap(__float_as_uint(v), __float_as_uint(v), false, false); v = __uint_as_float(r[0]) + __uint_as_float(r[1]); }
  { auto r = __builtin_amdgcn_permlane32_swap(__float_as_uint(v), __float_as_uint(v), false, false); v = __uint_as_float(r[0]) + __uint_as_float(r[1]); }
  return v;
}
__device__ __forceinline__ void store_bf16x4(bf16_t* p, f32x4 v) { u32x2 w; w.x = cvt_pk_bf16(v[0], v[1]); w.y = cvt_pk_bf16(v[2], v[3]); *(u32x2*)p = w; }

namespace pg8 {
constexpr int BM = 256, BK = 64, HALF = 128, HTB = HALF * BK * 2, STAGE_BYTES = 8 * HTB, NXCD = 8, WGM = 8;
__device__ __forceinline__ int lds_byte(int r, int c) { const int st = (r >> 4) * 2 + (c >> 5), rr = r & 15, cc = c & 31, ob = rr * 64 + cc * 2; return st * 1024 + (ob ^ (((ob >> 9) & 1) << 5)); }
__device__ __forceinline__ void stage_rc(int b, int& R, int& C) { const int st = b / 1024, sb = b % 1024, swz = sb ^ (((sb >> 9) & 1) << 5); R = (st >> 1) * 16 + swz / 64; C = (st & 1) * 32 + (swz % 64) / 2; }
struct Unit { int pm, pn, ko; };
struct Gemm { const bf16_t* A; const bf16_t* Bt; int M, N, K, lda, ldb; };
struct StaticOrder {
  int nM, nN, nwg, G, c, pm0;
  __device__ void init(int M, int N, int G_, int c_, int pm0_) { pm0 = pm0_; nM = M / BM - pm0_; nN = N / BM; nwg = nM * nN; G = G_; c = c_; }
  __device__ bool next(int i, Unit& u) const {
    const long L = (long)i * G + c; if (L >= nwg) return false;
    int wgid = (int)L; { const int q = nwg / NXCD, r = nwg % NXCD, xcd = wgid % NXCD, off = wgid / NXCD; wgid = (xcd < r ? xcd * (q + 1) : r * (q + 1) + (xcd - r) * q) + off; }
    const int nig = WGM * nN, gid = wgid / nig, fm = gid * WGM, gsz = (nM - fm) < WGM ? (nM - fm) : WGM;
    u.pm = fm + ((wgid % nig) % gsz) + pm0; u.pn = (wgid % nig) / gsz; u.ko = 0; return true;
  }
};

struct SplitKOrder {
  int nN, nwg, G, c, ks;
  __device__ void init(int N, int nslices, int ks_, int G_, int c_) { nN = N / BM; nwg = nN * nslices; G = G_; c = c_; ks = ks_; }
  __device__ bool next(int i, Unit& u) const { const long L = (long)i * G + c; if (L >= nwg) return false; u.pm = 0; u.pn = (int)L % nN; u.ko = ((int)L / nN) * ks; return true; }
};
template <class Epi, class Sched>
__device__ __forceinline__ void gemm_phase(LAS unsigned char* lds, const Gemm g, const Sched& S, const Epi& E) {
  const int tid = tid_(), wid = __builtin_amdgcn_readfirstlane(tid >> 6), lane = tid & 63, wr = wid >> 2, wc = wid & 3, fr = lane & 15, fq = lane >> 4;
  const int K = g.K, nt = K / BK;
  unsigned voffA[2], voffB[2];
#pragma unroll
  for (int i = 0; i < 2; ++i) { int R, C; stage_rc(tid * 16 + i * 8192, R, C);
    voffA[i] = (unsigned)(R * g.lda + C) * 2u; voffB[i] = (unsigned)(R * g.ldb + C) * 2u; }
  const size_t kstep = (size_t)(BK * 2);
  const size_t hstepA = (size_t)HALF * g.lda * 2, hstepB = (size_t)HALF * g.ldb * 2;
  const size_t tstepA = 2 * hstepA, tstepB = 2 * hstepB;
  const unsigned ldsw = (unsigned)wid * 1024u;
  const int aoff = lds_byte(wr * 64 + fr, fq * 8), boff = lds_byte(wc * 32 + fr, fq * 8);
#define PG8_SA(b, h) (((b) * 2 + (h)) * HTB)
#define PG8_SB(b, h) ((4 + (b) * 2 + (h)) * HTB)
#define PG8_STAGE(bufoff, gbase, voff) do { _Pragma("unroll") for (int _i = 0; _i < 2; ++_i) \
    __builtin_amdgcn_global_load_lds((const unsigned*)((const char*)(gbase) + (voff)[_i]), (LAS unsigned*)(lds + (bufoff) + ldsw + _i * 8192), 16, 0, 0); } while (0)
#define PG8_LDA(dst, b, h) do { _Pragma("unroll") for (int m = 0; m < 4; ++m) _Pragma("unroll") for (int k = 0; k < 2; ++k) dst[m][k] = *(const LAS bf16x8*)(lds + PG8_SA(b, h) + aoff + m * 2048 + k * 1024); } while (0)
#define PG8_LDB(dst, b, h) do { _Pragma("unroll") for (int n = 0; n < 2; ++n) _Pragma("unroll") for (int k = 0; k < 2; ++k) dst[n][k] = *(const LAS bf16x8*)(lds + PG8_SB(b, h) + boff + n * 2048 + k * 1024); } while (0)
#define PG8_MMA(ai, bj, At, Bt) do { __builtin_amdgcn_s_setprio(1); _Pragma("unroll") for (int m = 0; m < 4; ++m) _Pragma("unroll") for (int n = 0; n < 2; ++n) _Pragma("unroll") for (int k = 0; k < 2; ++k) \
    acc[ai][bj][m][n] = __builtin_amdgcn_mfma_f32_16x16x32_bf16(Bt[n][k], At[m][k], acc[ai][bj][m][n], 0, 0, 0); __builtin_amdgcn_s_setprio(0); } while (0)
#define PG8_WAIT_V(n) asm volatile("s_waitcnt vmcnt(" #n ")" ::: "memory")
#define PG8_WAIT_L(n) asm volatile("s_waitcnt lgkmcnt(" #n ")" ::: "memory")
#define PG8_BAR __builtin_amdgcn_s_barrier()
#define PG8_SCHED __builtin_amdgcn_sched_barrier(0)
  Unit cur, nxt; int ui = 0;
  if (!S.next(0, cur)) return;
  f32x4 acc[2][2][4][2];
#pragma unroll
  for (int a = 0; a < 2; ++a)
#pragma unroll
    for (int b = 0; b < 2; ++b)
#pragma unroll
      for (int m = 0; m < 4; ++m)
#pragma unroll
        for (int n = 0; n < 2; ++n) acc[a][b][m][n] = (f32x4){0.f, 0.f, 0.f, 0.f};
  bf16x8 At[4][2], B0[2][2], B1[2][2];
  const char* cA = (const char*)g.A + (size_t)cur.pm * tstepA + (size_t)cur.ko * 2; const char* cB = (const char*)g.Bt + (size_t)cur.pn * tstepB + (size_t)cur.ko * 2;
  PG8_STAGE(PG8_SB(0, 0), cB, voffB); PG8_STAGE(PG8_SA(0, 0), cA, voffA); PG8_STAGE(PG8_SB(0, 1), cB + hstepB, voffB); PG8_STAGE(PG8_SA(0, 1), cA + hstepA, voffA);
  if (wr == 1) PG8_BAR;
  PG8_WAIT_V(4); PG8_BAR;
  PG8_STAGE(PG8_SB(1, 0), cB + kstep, voffB); PG8_STAGE(PG8_SA(1, 0), cA + kstep, voffA); PG8_STAGE(PG8_SB(1, 1), cB + hstepB + kstep, voffB);
  PG8_WAIT_V(6); PG8_BAR;
  for (;;) {
    const bool has_next = S.next(ui + 1, nxt);
    const char* nA = has_next ? (const char*)g.A + (size_t)nxt.pm * tstepA + (size_t)nxt.ko * 2 : cA; const char* nB = has_next ? (const char*)g.Bt + (size_t)nxt.pn * tstepB + (size_t)nxt.ko * 2 : cB;
    for (int t = 0; t < nt; t += 2) {
      const bool last = (t == nt - 2);
      const char* a1 = cA + (size_t)(t + 1) * kstep;
      const char* a2 = last ? nA : cA + (size_t)(t + 2) * kstep; const char* b2 = last ? nB : cB + (size_t)(t + 2) * kstep;
      const char* a3 = a2 + kstep; const char* b3 = b2 + kstep;
      PG8_LDB(B0, 0, 0); PG8_SCHED; PG8_LDA(At, 0, 0); PG8_STAGE(PG8_SA(1, 1), a1 + hstepA, voffA);
      PG8_WAIT_L(8); PG8_BAR; PG8_WAIT_L(0); PG8_MMA(0, 0, At, B0); PG8_BAR; PG8_SCHED;
      PG8_LDB(B1, 0, 1); PG8_STAGE(PG8_SB(0, 0), b2, voffB);
      PG8_BAR; PG8_WAIT_L(0); PG8_MMA(0, 1, At, B1); PG8_BAR;
      PG8_LDA(At, 0, 1); PG8_STAGE(PG8_SA(0, 0), a2, voffA);
      PG8_BAR; PG8_WAIT_L(0); PG8_MMA(1, 0, At, B0); PG8_BAR; PG8_SCHED;
      PG8_STAGE(PG8_SB(0, 1), b2 + hstepB, voffB);
      PG8_WAIT_V(6); PG8_BAR; PG8_MMA(1, 1, At, B1); PG8_BAR;
      PG8_LDB(B0, 1, 0); PG8_SCHED; PG8_LDA(At, 1, 0); PG8_STAGE(PG8_SA(0, 1), a2 + hstepA, voffA);
      PG8_WAIT_L(8); PG8_BAR; PG8_WAIT_L(0); PG8_MMA(0, 0, At, B0); PG8_BAR; PG8_SCHED;
      PG8_LDB(B1, 1, 1); PG8_STAGE(PG8_SB(1, 0), b3, voffB);
      PG8_BAR; PG8_WAIT_L(0); PG8_MMA(0, 1, At, B1); PG8_BAR;
      PG8_LDA(At, 1, 1); PG8_STAGE(PG8_SA(1, 0), a3, voffA);
      PG8_BAR; PG8_WAIT_L(0); PG8_MMA(1, 0, At, B0); PG8_BAR; PG8_SCHED;
      PG8_STAGE(PG8_SB(1, 1), b3 + hstepB, voffB);
      PG8_WAIT_V(6); PG8_BAR; PG8_MMA(1, 1, At, B1); PG8_BAR;
    }
    E(acc, cur, wr, wc, fr, fq);
    if (!has_next) break;
#pragma unroll
    for (int a = 0; a < 2; ++a)
#pragma unroll
      for (int b = 0; b < 2; ++b)
#pragma unroll
        for (int m = 0; m < 4; ++m)
#pragma unroll
          for (int n = 0; n < 2; ++n) acc[a][b][m][n] = (f32x4){0.f, 0.f, 0.f, 0.f};
    cur = nxt; cA = nA; cB = nB; ++ui;
  }
  PG8_WAIT_V(0);
  if (wr == 0) PG8_BAR;
  PG8_BAR;
#undef PG8_SA
#undef PG8_SB
#undef PG8_STAGE
#undef PG8_LDA
#undef PG8_LDB
#undef PG8_MMA
#undef PG8_WAIT_V
#undef PG8_WAIT_L
#undef PG8_BAR
#undef PG8_SCHED
}
}

#define EPI_LOOP(BODY) \
  const int row0 = u.pm * 256 + wr * 64 + fr, colt = u.pn * 256 + wc * 32 + 4 * fq; \
  _Pragma("unroll") for (int ai = 0; ai < 2; ++ai) _Pragma("unroll") for (int m = 0; m < 4; ++m) { const int row = row0 + ai * 128 + m * 16; (void)row; \
    _Pragma("unroll") for (int bj = 0; bj < 2; ++bj) _Pragma("unroll") for (int n = 0; n < 2; ++n) { const int col = colt + bj * 128 + n * 16; f32x4 v = acc[ai][bj][m][n]; BODY } }

struct EpiG1Even {
  float* QH; float* F; bf16_t* VH; bf16_t* G; bf16_t* CQ; const float* LBj;
  __device__ __forceinline__ void operator()(const f32x4 (&acc)[2][2][4][2], const pg8::Unit& u, int wr, int wc, int fr, int fq) const {
    const int pn = u.pn;
    EPI_LOOP(
      if (pn < 2) { f32x4 o; for (int j = 0; j < 4; ++j) o[j] = siluf_(v[j]); *(f32x4*)(QH + (size_t)row * 512 + col) = o; }
      else if (pn < 6) { const int c = col - 512; const f32x4 lb = *(const f32x4*)(LBj + c); f32x4 o; for (int j = 0; j < 4; ++j) o[j] = lb[j] + (1.f - lb[j]) * sigmoidf_(v[j]); *(f32x4*)(F + (size_t)row * 1024 + c) = o; }
      else if (pn < 8) { store_bf16x4(VH + (size_t)row * 512 + (col - 1536), v); }
      else if (pn < 10) { f32x4 o; for (int j = 0; j < 4; ++j) o[j] = siluf_(v[j]); store_bf16x4(G + (size_t)row * 512 + (col - 2048), o); }
      else { store_bf16x4(CQ + (size_t)row * 768 + (col - 2560), v); }
    )
  }
};
struct EpiG1Odd {
  bf16_t* DQK; bf16_t* DV; float* RQ; float* RK; bf16_t* RV; bf16_t* RG; const float* ROPE;
  __device__ __forceinline__ void operator()(const f32x4 (&acc)[2][2][4][2], const pg8::Unit& u, int wr, int wc, int fr, int fq) const {
    const int pn = u.pn;
    if (pn == 6 || pn == 7) {
      float* dst = pn == 6 ? RQ : RK; const float sc = pn == 6 ? 1.f : 0.125f; const int ax = wc & 1;
      const int row0 = u.pm * 256 + wr * 64 + fr, colt = wc * 32 + 4 * fq;
#pragma unroll
      for (int ai = 0; ai < 2; ++ai)
#pragma unroll
        for (int m = 0; m < 4; ++m) { const int row = row0 + ai * 128 + m * 16;
          f32x4 cs = {1.f, 1.f, 1.f, 1.f}, sn = {0.f, 0.f, 0.f, 0.f};
          if (row >= NCTX) { const int t = row - NCTX; const int pos = ax ? (t & 63) : (t >> 6); const float* rp = ROPE + pos * 32 + (4 * fq) * 2;
            const f32x4 a = *(const f32x4*)rp, b = *(const f32x4*)(rp + 4); cs = (f32x4){a[0], a[2], b[0], b[2]}; sn = (f32x4){a[1], a[3], b[1], b[3]}; }
#pragma unroll
          for (int bj = 0; bj < 2; ++bj) { const f32x4 x0 = acc[ai][bj][m][0] * sc, x1 = acc[ai][bj][m][1] * sc;
            const f32x4 o0 = x0 * cs - x1 * sn, o1 = x1 * cs + x0 * sn; const int col = colt + bj * 128;
            *(f32x4*)(dst + (size_t)row * 256 + col) = o0; *(f32x4*)(dst + (size_t)row * 256 + col + 16) = o1; } }
      return;
    }
    EPI_LOOP(
      if (pn < 4) { store_bf16x4(DQK + (size_t)row * 1024 + col, v); }
      else if (pn < 6) { store_bf16x4(DV + (size_t)row * 512 + (col - 1024), v); }
      else if (pn < 10) { store_bf16x4(RV + (size_t)row * 512 + (col - 2048), v); }
      else { f32x4 o; for (int j = 0; j < 4; ++j) o[j] = siluf_(v[j]); store_bf16x4(RG + (size_t)row * 512 + (col - 2560), o); }
    )
  }
};
struct EpiBf16Off { bf16_t* O; int ldo, coff;
  __device__ __forceinline__ void operator()(const f32x4 (&acc)[2][2][4][2], const pg8::Unit& u, int wr, int wc, int fr, int fq) const {
    EPI_LOOP( store_bf16x4(O + (size_t)row * ldo + coff + col, v); ) } };
struct EpiSqRelu { bf16_t* O; int ldo;
  __device__ __forceinline__ void operator()(const f32x4 (&acc)[2][2][4][2], const pg8::Unit& u, int wr, int wc, int fr, int fq) const {
    EPI_LOOP( f32x4 o; for (int j = 0; j < 4; ++j) { const float r = fmaxf(v[j], 0.f); o[j] = r * r; } store_bf16x4(O + (size_t)row * ldo + col, o); ) } };
struct EpiResid {
  float* X; const float* gL; const float* gC; float* out; const float* Xin;
  __device__ __forceinline__ void operator()(const f32x4 (&acc)[2][2][4][2], const pg8::Unit& u, int wr, int wc, int fr, int fq) const {
    EPI_LOOP( const float* gp = row < NCTX ? gC : gL; const f32x4 gt = *(const f32x4*)(gp + col); float* xp = X + (size_t)row * DM + col;
      const float* rp = Xin ? Xin + (size_t)(row - NCTX) * DM + col : xp; const f32x4 r = *(const f32x4*)rp + gt * v;
      if (out) { if (row >= NCTX) *(f32x4*)(out + (size_t)(row - NCTX) * DM + col) = r; } else *(f32x4*)xp = r; ) } };

struct EpiPartial {
  float* PB; const float* gC; int ks;
  __device__ __forceinline__ void operator()(const f32x4 (&acc)[2][2][4][2], const pg8::Unit& u, int wr, int wc, int fr, int fq) const {
    float* pb = PB + (size_t)(u.ko / ks) * NCTX * DM;
    EPI_LOOP( const f32x4 gt = *(const f32x4*)(gC + col); *(f32x4*)(pb + (size_t)row * DM + col) = gt * v; ) } };

__device__ __forceinline__ int crow(int r, int hi) { return (r & 3) + 8 * (r >> 2) + 4 * hi; }
#define SBAR() __builtin_amdgcn_sched_barrier(0)
__device__ __forceinline__ void partialSM(f32x16& p0, f32x16& p1, float& m_reg, float& mn, float& alpha, const float C, const float thr) {
  float pmax = p0[0];
#pragma unroll
  for (int r = 1; r < 16; ++r) pmax = fmaxf(pmax, p0[r]);
#pragma unroll
  for (int r = 0; r < 16; ++r) pmax = fmaxf(pmax, p1[r]);
  { auto rr = __builtin_amdgcn_permlane32_swap(__float_as_uint(pmax), __float_as_uint(pmax), false, false);
    pmax = fmaxf(__uint_as_float(rr[0]), __uint_as_float(rr[1])); }
  if (__builtin_expect(__all(pmax - m_reg <= thr), 1)) { mn = m_reg; alpha = 1.f; }
  else { mn = fmaxf(m_reg, pmax); alpha = __builtin_amdgcn_exp2f((m_reg - mn) * C); m_reg = mn; }
  const float mnC = -mn * C;
#pragma unroll
  for (int r = 0; r < 16; ++r) p0[r] = fmaf(p0[r], C, mnC);
#pragma unroll
  for (int r = 0; r < 16; ++r) p1[r] = fmaf(p1[r], C, mnC);
#pragma unroll
  for (int r = 0; r < 16; ++r) p0[r] = __builtin_amdgcn_exp2f(p0[r]);
}
__device__ __forceinline__ void decideSM(const f32x16& p0, const f32x16& p1, float& m_reg, float& mn, float& alpha, const float C, const float thr) {
  float pmax = p0[0];
#pragma unroll
  for (int r = 1; r < 16; ++r) pmax = fmaxf(pmax, p0[r]);
#pragma unroll
  for (int r = 0; r < 16; ++r) pmax = fmaxf(pmax, p1[r]);
  { auto rr = __builtin_amdgcn_permlane32_swap(__float_as_uint(pmax), __float_as_uint(pmax), false, false);
    pmax = fmaxf(__uint_as_float(rr[0]), __uint_as_float(rr[1])); }
  if (__builtin_expect(__all(pmax - m_reg <= thr), 1)) { mn = m_reg; alpha = 1.f; }
  else { mn = fmaxf(m_reg, pmax); alpha = __builtin_amdgcn_exp2f((m_reg - mn) * C); m_reg = mn; }
}
__device__ __forceinline__ void finishSM(f32x16& p0, f32x16& p1, float alpha, float& l_reg, bf16x8& pa0, bf16x8& pa1, bf16x8& pa2, bf16x8& pa3) {
#pragma unroll
  for (int r = 0; r < 16; ++r) p1[r] = __builtin_amdgcn_exp2f(p1[r]);
  float ps = 0;
#pragma unroll
  for (int r = 0; r < 16; ++r) ps += p0[r];
#pragma unroll
  for (int r = 0; r < 16; ++r) ps += p1[r];
  { auto rr = __builtin_amdgcn_permlane32_swap(__float_as_uint(ps), __float_as_uint(ps), false, false);
    ps = __uint_as_float(rr[0]) + __uint_as_float(rr[1]); }
  l_reg = l_reg * alpha + ps;
#define PK4(P, BASE, OUT) do { u32x4 w = {cvtb(P[BASE + 0], P[BASE + 1]), cvtb(P[BASE + 2], P[BASE + 3]), \
    cvtb(P[BASE + 4], P[BASE + 5]), cvtb(P[BASE + 6], P[BASE + 7])}; OUT = *reinterpret_cast<bf16x8*>(&w); } while (0)
  PK4(p0, 0, pa0); PK4(p0, 8, pa1); PK4(p1, 0, pa2); PK4(p1, 8, pa3);
#undef PK4
}
template <int NQK>
__device__ __forceinline__ void qkt(f32x16& p0, f32x16& p1, const char* Ks, const bf16x8* qr, int r32, int hi) {
  constexpr int KROW = NQK * 32 + 16;
  p0 = f32x16{}; p1 = f32x16{};
#pragma unroll
  for (int d0 = 0; d0 < NQK; ++d0) { const int cb = (d0 * 16 + hi * 8) * 2;
    bf16x8 b0 = *reinterpret_cast<const bf16x8*>(Ks + r32 * KROW + cb);
    bf16x8 b1 = *reinterpret_cast<const bf16x8*>(Ks + (32 + r32) * KROW + cb);
    p0 = __builtin_amdgcn_mfma_f32_32x32x16_bf16(b0, qr[d0], p0, 0, 0, 0);
    p1 = __builtin_amdgcn_mfma_f32_32x32x16_bf16(b1, qr[d0], p1, 0, 0, 0); }
}
template <int NQK>
__device__ __forceinline__ void qkt_mi(f32x16& p0, f32x16& p1, const char* Ks, const bf16x8* qr, int r32, int hi, const f32x16& minit) {
  constexpr int KROW = NQK * 32 + 16;
#pragma unroll
  for (int d0 = 0; d0 < NQK; ++d0) { const int cb = (d0 * 16 + hi * 8) * 2;
    bf16x8 b0 = *reinterpret_cast<const bf16x8*>(Ks + r32 * KROW + cb);
    bf16x8 b1 = *reinterpret_cast<const bf16x8*>(Ks + (32 + r32) * KROW + cb);
    if (d0 == 0) { p0 = __builtin_amdgcn_mfma_f32_32x32x16_bf16(b0, qr[0], minit, 0, 0, 0); p1 = __builtin_amdgcn_mfma_f32_32x32x16_bf16(b1, qr[0], minit, 0, 0, 0); }
    else { p0 = __builtin_amdgcn_mfma_f32_32x32x16_bf16(b0, qr[d0], p0, 0, 0, 0); p1 = __builtin_amdgcn_mfma_f32_32x32x16_bf16(b1, qr[d0], p1, 0, 0, 0); } }
}
__device__ __forceinline__ void decide_mi(f32x16& p0, f32x16& p1, f32x16& minit, float& M, float& alpha, const float thr2, const bool first) {
  float pmax = p0[0];
#pragma unroll
  for (int r = 1; r < 16; ++r) pmax = fmaxf(pmax, p0[r]);
#pragma unroll
  for (int r = 0; r < 16; ++r) pmax = fmaxf(pmax, p1[r]);
  { auto rr = __builtin_amdgcn_permlane32_swap(__float_as_uint(pmax), __float_as_uint(pmax), false, false);
    pmax = fmaxf(__uint_as_float(rr[0]), __uint_as_float(rr[1])); }
  if (__builtin_expect(!first && __all(pmax <= thr2), 1)) { alpha = 1.f; }
  else { const float delta = first ? pmax : fmaxf(pmax, 0.f); alpha = first ? 1.f : __builtin_amdgcn_exp2f(-delta); M += delta;
#pragma unroll
    for (int r = 0; r < 16; ++r) { p0[r] -= delta; p1[r] -= delta; minit[r] = -M; } }
}
__device__ __forceinline__ int v_st(int k, int c) { const int kk = k; return ((kk >> 3) * 4 + (c >> 5)) * 512 + ((kk & 7) * 32 + (c & 31)) * 2; }
__device__ __forceinline__ int v_rd_base(int lane) { return ((lane & 3) << 3) | (((lane >> 2) & 3) << 6) | (((lane >> 4) & 1) << 5) | (((lane >> 5) & 1) << 8); }
constexpr int v_rd_off(int d0, int ks, int half) { return d0 * 512 + ks * 4096 + half * 2048; }
template <int OFF> __device__ __forceinline__ s16x4 tr_read(int vb) {
  s16x4 r; asm volatile("ds_read_b64_tr_b16 %0, %1 offset:%2" : "=&v"(r) : "v"(vb), "i"(OFF) : "memory"); return r;
}
template <int D0> __device__ __forceinline__ void pv_one(f32x16& od, int vb, bf16x8 pa0, bf16x8 pa1, bf16x8 pa2, bf16x8 pa3) {
  const s16x4 l0 = tr_read<v_rd_off(D0, 0, 0)>(vb), h0 = tr_read<v_rd_off(D0, 0, 1)>(vb), l1 = tr_read<v_rd_off(D0, 1, 0)>(vb), h1 = tr_read<v_rd_off(D0, 1, 1)>(vb);
  const s16x4 l2 = tr_read<v_rd_off(D0, 2, 0)>(vb), h2 = tr_read<v_rd_off(D0, 2, 1)>(vb), l3 = tr_read<v_rd_off(D0, 3, 0)>(vb), h3 = tr_read<v_rd_off(D0, 3, 1)>(vb);
  asm volatile("s_waitcnt lgkmcnt(0)" ::: "memory"); SBAR();
#define PK(L, H) (bf16x8){L[0], L[1], L[2], L[3], H[0], H[1], H[2], H[3]}
  od = __builtin_amdgcn_mfma_f32_32x32x16_bf16(pa0, PK(l0, h0), od, 0, 0, 0);
  od = __builtin_amdgcn_mfma_f32_32x32x16_bf16(pa1, PK(l1, h1), od, 0, 0, 0);
  od = __builtin_amdgcn_mfma_f32_32x32x16_bf16(pa2, PK(l2, h2), od, 0, 0, 0);
  od = __builtin_amdgcn_mfma_f32_32x32x16_bf16(pa3, PK(l3, h3), od, 0, 0, 0);
#undef PK
}
template <int D0> __device__ __forceinline__ void pv_one_sm(f32x16& od, int vb, bf16x8 pa0, bf16x8 pa1, bf16x8 pa2, bf16x8 pa3, f32x16& q0, f32x16& q1, const float C, const float mnC) {
  const s16x4 l0 = tr_read<v_rd_off(D0, 0, 0)>(vb), h0 = tr_read<v_rd_off(D0, 0, 1)>(vb), l1 = tr_read<v_rd_off(D0, 1, 0)>(vb), h1 = tr_read<v_rd_off(D0, 1, 1)>(vb);
  const s16x4 l2 = tr_read<v_rd_off(D0, 2, 0)>(vb), h2 = tr_read<v_rd_off(D0, 2, 1)>(vb), l3 = tr_read<v_rd_off(D0, 3, 0)>(vb), h3 = tr_read<v_rd_off(D0, 3, 1)>(vb);
  asm volatile("s_waitcnt lgkmcnt(0)" ::: "memory"); SBAR();
#define PK(L, H) (bf16x8){L[0], L[1], L[2], L[3], H[0], H[1], H[2], H[3]}
  od = __builtin_amdgcn_mfma_f32_32x32x16_bf16(pa0, PK(l0, h0), od, 0, 0, 0);
  od = __builtin_amdgcn_mfma_f32_32x32x16_bf16(pa1, PK(l1, h1), od, 0, 0, 0);
  od = __builtin_amdgcn_mfma_f32_32x32x16_bf16(pa2, PK(l2, h2), od, 0, 0, 0);
  od = __builtin_amdgcn_mfma_f32_32x32x16_bf16(pa3, PK(l3, h3), od, 0, 0, 0);
#undef PK
  if (D0 < 2) {
#pragma unroll
    for (int r = 8 * D0; r < 8 * D0 + 8; ++r) q0[r] = __builtin_amdgcn_exp2f(fmaf(q0[r], C, mnC));
  } else {
#pragma unroll
    for (int r = 8 * (D0 - 2); r < 8 * (D0 - 2) + 8; ++r) q1[r] = fmaf(q1[r], C, mnC);
  }
}
__device__ __forceinline__ void pv_sm(f32x16* o, int vb, bf16x8 pa0, bf16x8 pa1, bf16x8 pa2, bf16x8 pa3, f32x16& q0, f32x16& q1, const float C, const float mn) {
  const float mnC = -mn * C;
  pv_one_sm<0>(o[0], vb, pa0, pa1, pa2, pa3, q0, q1, C, mnC); pv_one_sm<1>(o[1], vb, pa0, pa1, pa2, pa3, q0, q1, C, mnC);
  pv_one_sm<2>(o[2], vb, pa0, pa1, pa2, pa3, q0, q1, C, mnC); pv_one_sm<3>(o[3], vb, pa0, pa1, pa2, pa3, q0, q1, C, mnC);
}
__device__ __forceinline__ void pv_d0(f32x16* o, int vb, bf16x8 pa0, bf16x8 pa1, bf16x8 pa2, bf16x8 pa3) {
  pv_one<0>(o[0], vb, pa0, pa1, pa2, pa3); pv_one<1>(o[1], vb, pa0, pa1, pa2, pa3); pv_one<2>(o[2], vb, pa0, pa1, pa2, pa3); pv_one<3>(o[3], vb, pa0, pa1, pa2, pa3);
}

template <int D0> __device__ __forceinline__ void pv_one_mi(f32x16& od, int vb, bf16x8 pa0, bf16x8 pa1, bf16x8 pa2, bf16x8 pa3, f32x16& q0) {
  const s16x4 l0 = tr_read<v_rd_off(D0, 0, 0)>(vb), h0 = tr_read<v_rd_off(D0, 0, 1)>(vb), l1 = tr_read<v_rd_off(D0, 1, 0)>(vb), h1 = tr_read<v_rd_off(D0, 1, 1)>(vb);
  const s16x4 l2 = tr_read<v_rd_off(D0, 2, 0)>(vb), h2 = tr_read<v_rd_off(D0, 2, 1)>(vb), l3 = tr_read<v_rd_off(D0, 3, 0)>(vb), h3 = tr_read<v_rd_off(D0, 3, 1)>(vb);
  asm volatile("s_waitcnt lgkmcnt(0)" ::: "memory"); SBAR();
#define PK(L, H) (bf16x8){L[0], L[1], L[2], L[3], H[0], H[1], H[2], H[3]}
  od = __builtin_amdgcn_mfma_f32_32x32x16_bf16(pa0, PK(l0, h0), od, 0, 0, 0);
  od = __builtin_amdgcn_mfma_f32_32x32x16_bf16(pa1, PK(l1, h1), od, 0, 0, 0);
  od = __builtin_amdgcn_mfma_f32_32x32x16_bf16(pa2, PK(l2, h2), od, 0, 0, 0);
  od = __builtin_amdgcn_mfma_f32_32x32x16_bf16(pa3, PK(l3, h3), od, 0, 0, 0);
#undef PK
#pragma unroll
  for (int r = 4 * D0; r < 4 * D0 + 4; ++r) q0[r] = __builtin_amdgcn_exp2f(q0[r]);
}
__device__ __forceinline__ void pv_mi(f32x16* o, int vb, bf16x8 pa0, bf16x8 pa1, bf16x8 pa2, bf16x8 pa3, f32x16& q0) {
  pv_one_mi<0>(o[0], vb, pa0, pa1, pa2, pa3, q0); pv_one_mi<1>(o[1], vb, pa0, pa1, pa2, pa3, q0);
  pv_one_mi<2>(o[2], vb, pa0, pa1, pa2, pa3, q0); pv_one_mi<3>(o[3], vb, pa0, pa1, pa2, pa3, q0);
}
template <int NQK, int SD, bool MI>
__device__ __forceinline__ void attn_body(const bf16_t* __restrict__ Qb, int ldq, const bf16_t* __restrict__ Kh, int ldk, const bf16_t* __restrict__ Vh, int ldv,
                                          bf16_t* __restrict__ Ob, int ldo, int seq, float scale, char* lds) {
  constexpr int KROW = NQK * 32 + 16, KT = 64 * KROW, NP = NQK / 4, PPR = NQK * 2, SHM_V = 16384;
  const float C = scale * 1.4426950408889634f, thr = 8.f / scale;
  const int tid = tid_(), wid = tid >> 6, lane = tid & 63, r32 = lane & 31, hi = lane >> 5;
  char* V_lds = lds; char* K_lds = lds + 3 * SHM_V;
  float* wsl = (float*)(lds + 3 * SHM_V + 3 * KT) + wid * 64; float* li_l = wsl; float* al_l = wsl + 32;
  float m_reg = -1e30f, l_reg = 0; f32x16 o[4] = {}; bf16x8 qr[NQK];
  const bf16_t* Qw = Qb + (long)(wid * 32 + r32) * ldq + hi * 8;
#pragma unroll
  for (int d0 = 0; d0 < NQK; ++d0) qr[d0] = *reinterpret_cast<const bf16x8*>(Qw + d0 * 16);
  f32x16 minit = {}; float Mref = 0.f; const float thr2 = 8.f * 1.4426950408889634f;
  if constexpr (MI) {
#pragma unroll
    for (int d0 = 0; d0 < NQK; ++d0) { u32x4 w = *reinterpret_cast<u32x4*>(&qr[d0]);
#pragma unroll
      for (int e = 0; e < 4; ++e) { const float lo = __uint_as_float(w[e] << 16) * C, hi2 = __uint_as_float(w[e] & 0xffff0000u) * C; w[e] = cvtb(lo, hi2); }
      qr[d0] = *reinterpret_cast<bf16x8*>(&w); }
  }
  constexpr bool RECOMP = false;
  const int p_voffV = ((tid >> 4) * ldv + (tid & 15) * 8) * 2, p_vstV = v_st(tid >> 4, (tid & 15) * 8);
  const int p_voffK = ((tid >> 3) * ldk + (tid & 7) * 8) * 2, p_ldsK = (tid >> 3) * KROW + (tid & 7) * 16;
#define STG_T() int _t = tid; if constexpr (RECOMP) asm volatile("" : "+v"(_t));
#define VOFFV() (RECOMP ? ((_t >> 4) * ldv + (_t & 15) * 8) * 2 : p_voffV)
#define VSTV() (RECOMP ? v_st(_t >> 4, (_t & 15) * 8) : p_vstV)
#define VOFFK() (RECOMP ? ((_t >> 3) * ldk + (_t & 7) * 8) * 2 : p_voffK)
#define LDSK() (RECOMP ? (_t >> 3) * KROW + (_t & 7) * 16 : p_ldsK)
  const auto rK = __builtin_amdgcn_make_buffer_rsrc((void*)Kh, 0, 0x7ffffff0, 0x00020000);
  const auto rV = __builtin_amdgcn_make_buffer_rsrc((void*)Vh, 0, 0x7ffffff0, 0x00020000);
  const int vb0 = (int)(uintptr_t)V_lds + v_rd_base(lane);
  struct { u32x4 vs0, vs1; u32x4 ks[NP]; } sr_[SD];
#define SLOAD(i, k0) do { STG_T() const int _sV = (k0) * ldv * 2, _sK = (k0) * ldk * 2, _vv = VOFFV(), _vk = VOFFK(); \
    sr_[i].vs0 = __builtin_amdgcn_raw_buffer_load_b128(rV, _vv, _sV, 0); sr_[i].vs1 = __builtin_amdgcn_raw_buffer_load_b128(rV, _vv, _sV + 32 * ldv * 2, 0); \
    _Pragma("unroll") for (int _p = 0; _p < NP; ++_p) sr_[i].ks[_p] = __builtin_amdgcn_raw_buffer_load_b128(rK, _vk + _p * 128, _sK, 0); } while (0)
#define SWRITE(b, i) do { STG_T() const int _sv = VSTV(), _sk = LDSK(); *(u32x4*)(V_lds + (b) * SHM_V + _sv) = sr_[i].vs0; *(u32x4*)(V_lds + (b) * SHM_V + _sv + 8192) = sr_[i].vs1; \
    _Pragma("unroll") for (int _p = 0; _p < NP; ++_p) *(u32x4*)(K_lds + (b) * KT + _sk + _p * 128) = sr_[i].ks[_p]; } while (0)
#define SWAIT() do { if constexpr (SD == 2) { if constexpr (NP == 1) asm volatile("s_waitcnt vmcnt(3)" ::: "memory"); else asm volatile("s_waitcnt vmcnt(5)" ::: "memory"); } else asm volatile("s_waitcnt vmcnt(0)" ::: "memory"); } while (0)
#define RESC(a) do { if (__any((a) < 1.f)) { if (hi == 0) al_l[r32] = (a); asm volatile("s_waitcnt lgkmcnt(0)" ::: "memory"); \
    _Pragma("unroll") for (int d = 0; d < 4; ++d) _Pragma("unroll") for (int r = 0; r < 16; ++r) o[d][r] *= al_l[crow(r, hi)]; } } while (0)
  f32x16 pA0, pA1, pB0, pB1; float mnA, mnB, alA, alB; bf16x8 pa0, pa1, pa2, pa3; const int NT = seq / 64;
  constexpr int SE = 0, SO = SD - 1;
  if (__builtin_amdgcn_readfirstlane(tid) >= 256) __builtin_amdgcn_s_setprio(1);
  __syncthreads();
#define QKT(P0, P1, KS) do { if constexpr (MI) qkt_mi<NQK>(P0, P1, KS, qr, r32, hi, minit); else qkt<NQK>(P0, P1, KS, qr, r32, hi); } while (0)
#define DECIDE(P0, P1, MN, AL) do { if constexpr (MI) decide_mi(P0, P1, minit, Mref, AL, thr2, false); else decideSM(P0, P1, m_reg, MN, AL, C, thr); } while (0)
#define PVSM(VB, P0, P1, MN) do { if constexpr (MI) pv_mi(o, VB, pa0, pa1, pa2, pa3, P0); else pv_sm(o, VB, pa0, pa1, pa2, pa3, P0, P1, C, MN); } while (0)
  SLOAD(SE, 0); asm volatile("s_waitcnt vmcnt(0)" ::: "memory"); SWRITE(0, SE); __syncthreads();
  if constexpr (MI) { qkt_mi<NQK>(pA0, pA1, K_lds, qr, r32, hi, minit); decide_mi(pA0, pA1, minit, Mref, alA, thr2, true);
#pragma unroll
    for (int r = 0; r < 16; ++r) pA0[r] = __builtin_amdgcn_exp2f(pA0[r]); }
  else { qkt<NQK>(pA0, pA1, K_lds, qr, r32, hi); partialSM(pA0, pA1, m_reg, mnA, alA, C, thr); }
  SLOAD(SO, 64); if constexpr (SD == 2) { if (2 < NT) SLOAD(SE, 2 * 64); }
  SWAIT(); SWRITE(1, SO); __syncthreads();
  int rp = 0, rc = 1, rn = 2;
#define ROT() do { const int _r = rp; rp = rc; rc = rn; rn = _r; } while (0)
  for (int j = 1; j + 1 < NT; j += 2) {
    SBAR(); QKT(pB0, pB1, K_lds + rc * KT);
    finishSM(pA0, pA1, alA, l_reg, pa0, pa1, pa2, pa3); DECIDE(pB0, pB1, mnB, alB); SBAR();
    SLOAD(SO, (j + SD) * 64); SBAR();
    PVSM(vb0 + rp * SHM_V, pB0, pB1, mnB);
    SWAIT(); SWRITE(rn, SE);
    RESC(alB); __syncthreads(); ROT();
    SBAR(); QKT(pA0, pA1, K_lds + rc * KT);
    finishSM(pB0, pB1, alB, l_reg, pa0, pa1, pa2, pa3); DECIDE(pA0, pA1, mnA, alA); SBAR();
    if (SD == 1 || j + 3 < NT) SLOAD(SE, (j + 1 + SD) * 64); SBAR();
    PVSM(vb0 + rp * SHM_V, pA0, pA1, mnA);
    SWAIT(); SWRITE(rn, SO);
    RESC(alA); __syncthreads(); ROT();
  }
  SBAR(); QKT(pB0, pB1, K_lds + rc * KT);
  finishSM(pA0, pA1, alA, l_reg, pa0, pa1, pa2, pa3); DECIDE(pB0, pB1, mnB, alB); SBAR();
  PVSM(vb0 + rp * SHM_V, pB0, pB1, mnB);
  RESC(alB);
  finishSM(pB0, pB1, alB, l_reg, pa0, pa1, pa2, pa3); SBAR();
  pv_d0(o, vb0 + rc * SHM_V, pa0, pa1, pa2, pa3);
#undef QKT
#undef DECIDE
#undef PVSM
#undef ROT
  if (hi == 0) li_l[r32] = l_reg; asm volatile("s_waitcnt lgkmcnt(0)" ::: "memory");
  float rli[16];
#pragma unroll
  for (int r = 0; r < 16; ++r) rli[r] = __builtin_amdgcn_rcpf(li_l[crow(r, hi)]);
  bf16_t* Ow = Ob + (long)(wid * 32) * ldo;
#pragma unroll
  for (int r = 0; r < 16; ++r) { const int orow = crow(r, hi);
#pragma unroll
    for (int d0 = 0; d0 < 4; ++d0) Ow[(long)orow * ldo + d0 * 32 + r32] = f2bf(o[d0][r] * rli[r]); }
  asm volatile("s_waitcnt vmcnt(0)" ::: "memory");
  __builtin_amdgcn_s_setprio(0);
  __syncthreads();
#undef STG_T
#undef VOFFV
#undef VSTV
#undef VOFFK
#undef LDSK
#undef SLOAD
#undef SWRITE
#undef SWAIT
#undef RESC
}

__device__ __forceinline__ void conv_matrix(const float* __restrict__ src, int K, int N, int Npad, bf16_t* __restrict__ dst, const float* __restrict__ scale, float* tile) {
  const int nk = K / 64, nn = Npad / 64, tot = nk * nn;
  const int tid = tid_(), tx = tid & 63, ty = tid >> 6, nl = tid >> 3, ks = (tid & 7) * 8;
  for (int i0 = blockIdx.x; i0 < tot; i0 += 2 * gridDim.x) {
    const int i1 = i0 + gridDim.x; const bool has1 = i1 < tot;
    const int k0a = (i0 % nk) * 64, n0a = (i0 / nk) * 64, k0b = has1 ? (i1 % nk) * 64 : 0, n0b = has1 ? (i1 / nk) * 64 : 0;
    float va[8], vb[8];
#pragma unroll
    for (int i = 0; i < 8; ++i) { const int k = k0a + ty + 8 * i, n = n0a + tx; float v = (n < N) ? src[(size_t)k * N + n] : 0.f; if (scale) v *= scale[k]; va[i] = v; }
    if (has1) {
#pragma unroll
      for (int i = 0; i < 8; ++i) { const int k = k0b + ty + 8 * i, n = n0b + tx; float v = (n < N) ? src[(size_t)k * N + n] : 0.f; if (scale) v *= scale[k]; vb[i] = v; }
    }
    __syncthreads();
#pragma unroll
    for (int i = 0; i < 8; ++i) { tile[(ty + 8 * i) * 65 + tx] = va[i]; if (has1) tile[4160 + (ty + 8 * i) * 65 + tx] = vb[i]; }
    __syncthreads();
    { float v[8];
#pragma unroll
      for (int j = 0; j < 8; ++j) v[j] = tile[(ks + j) * 65 + nl];
      u32x4 w = {cvt_pk_bf16(v[0], v[1]), cvt_pk_bf16(v[2], v[3]), cvt_pk_bf16(v[4], v[5]), cvt_pk_bf16(v[6], v[7])};
      *(u32x4*)(dst + (size_t)(n0a + nl) * K + k0a + ks) = w; }
    if (has1) { float v[8];
#pragma unroll
      for (int j = 0; j < 8; ++j) v[j] = tile[4160 + (ks + j) * 65 + nl];
      u32x4 w = {cvt_pk_bf16(v[0], v[1]), cvt_pk_bf16(v[2], v[3]), cvt_pk_bf16(v[4], v[5]), cvt_pk_bf16(v[6], v[7])};
      *(u32x4*)(dst + (size_t)(n0b + nl) * K + k0b + ks) = w; }
  }
}

__device__ __forceinline__ void norm_phase(float* __restrict__ X, bf16_t* __restrict__ H, const float* __restrict__ nw, const float* __restrict__ modL, const float* __restrict__ modC, int sh_off, int sc_off,
                                           const float* __restrict__ part, int nsl, const float* __restrict__ latsrc, const float* __restrict__ ctxsrc) {
  const int tid = tid_(); const int wid = tid >> 6, lane = tid & 63;
  const int stride = gridDim.x * 8;
  int r = blockIdx.x * 8 + wid;
  f32x4 nx[4];
#define NSRC(rr) ((rr) < NCTX ? (ctxsrc ? ctxsrc + (size_t)(rr) * DM : X + (size_t)(rr) * DM) : (latsrc ? latsrc + (size_t)((rr) - NCTX) * DM : X + (size_t)(rr) * DM))
  if (r < T_TOK) { const float* sp = NSRC(r);
#pragma unroll
    for (int i = 0; i < 4; ++i) nx[i] = *(const f32x4*)(sp + i * 256 + lane * 4);
  }
  for (; r < T_TOK; r += stride) {
    float* xr = X + (size_t)r * DM; f32x4 v[4]; float ss = 0.f;
#pragma unroll
    for (int i = 0; i < 4; ++i) v[i] = nx[i];
    const int rn = r + stride;
    if (rn < T_TOK) { const float* sp = NSRC(rn);
#pragma unroll
      for (int i = 0; i < 4; ++i) nx[i] = *(const f32x4*)(sp + i * 256 + lane * 4);
    }
    if (r < NCTX && nsl > 0) {
      for (int sl = 0; sl < nsl; ++sl) { const float* pr = part + ((size_t)sl * NCTX + r) * DM;
#pragma unroll
        for (int i = 0; i < 4; ++i) v[i] += *(const f32x4*)(pr + i * 256 + lane * 4); }
#pragma unroll
      for (int i = 0; i < 4; ++i) *(f32x4*)(xr + i * 256 + lane * 4) = v[i];
    }
#pragma unroll
    for (int i = 0; i < 4; ++i) ss += v[i][0] * v[i][0] + v[i][1] * v[i][1] + v[i][2] * v[i][2] + v[i][3] * v[i][3];
    ss = wave_sum(ss); const float rstd = rsqrtf(ss * (1.f / DM) + EPSN);
    const float* md = r < NCTX ? modC : modL;
#pragma unroll
    for (int i = 0; i < 4; ++i) { const int col = i * 256 + lane * 4; const f32x4 w = *(const f32x4*)(nw + col), sc = *(const f32x4*)(md + sc_off + col), sh = *(const f32x4*)(md + sh_off + col);
      f32x4 h; for (int j = 0; j < 4; ++j) h[j] = (v[i][j] * rstd) * w[j] * (1.f + sc[j]) + sh[j];
      store_bf16x4(H + (size_t)r * DM + col, h); }
  }
}
#undef NSRC

__device__ __forceinline__ float rope_lane(float x, int lane, int t, const float* __restrict__ ROPE) {
  const int ax = lane >> 5, i = lane & 15, pos = ax ? (t & 63) : (t >> 6);
  const float cs = ROPE[pos * 32 + i * 2], sn = ROPE[pos * 32 + i * 2 + 1];
  const float pr = __shfl_xor(x, 16, 64);
  return (lane & 16) ? (x * cs + pr * sn) : (x * cs - pr * sn);
}

__device__ __forceinline__ void mla_prep(const bf16_t* __restrict__ U, const bf16_t* __restrict__ CQ, bf16_t* __restrict__ Qa, bf16_t* __restrict__ Ka, bf16_t* __restrict__ Va,
                                         const float* __restrict__ qkq, const float* __restrict__ qkk, const float* __restrict__ ROPE) {
  const int tid = tid_(); const int wid = tid >> 6, lane = tid & 63;
  const float wq0 = qkq[lane], wq1 = qkq[64 + lane], wq2 = qkq[128 + lane], wk0 = qkk[lane], wk1 = qkk[64 + lane], wk2 = qkk[128 + lane];
  auto do_row = [&](const int r) {
    const bf16_t* cq = CQ + (size_t)r * 768; float sq = 0.f, skv = 0.f;
#pragma unroll
    for (int i = 0; i < 6; ++i) { const float x = bf2f(cq[i * 64 + lane]); sq += x * x; }
#pragma unroll
    for (int i = 0; i < 4; ++i) { const float x = bf2f(cq[384 + i * 64 + lane]); skv += x * x; }
    sq = wave_sum(sq); skv = wave_sum(skv);
    const float rq = rsqrtf(sq * (1.f / 384.f) + EPSN), rkv = rsqrtf(skv * (1.f / 256.f) + EPSN);
    const float kr = bf2f(cq[640 + lane]);
    const bool lat = r >= NCTX; const int t = r - NCTX;
    const bf16_t* u = U + (size_t)r * 1792;
#pragma unroll
    for (int h = 0; h < 4; ++h) {
      float q0 = bf2f(u[h * 192 + lane]) * rq, q1 = bf2f(u[h * 192 + 64 + lane]) * rq, q2 = bf2f(u[h * 192 + 128 + lane]) * rq;
      float ss = wave_sum(q0 * q0 + q1 * q1 + q2 * q2); float rs = rsqrtf(ss * (1.f / 192.f) + EPSN);
      q0 = q0 * rs * wq0; q1 = q1 * rs * wq1; q2 = q2 * rs * wq2; if (lat) q2 = rope_lane(q2, lane, t, ROPE);
      bf16_t* qo = Qa + (size_t)r * 768 + h * 192; qo[lane] = f2bf(q0); qo[64 + lane] = f2bf(q1); qo[128 + lane] = f2bf(q2);
      const bf16_t* kv = u + 768 + h * 256;
      float k0 = bf2f(kv[lane]) * rkv, k1 = bf2f(kv[64 + lane]) * rkv; const float v0 = bf2f(kv[128 + lane]) * rkv, v1 = bf2f(kv[192 + lane]) * rkv;
      ss = wave_sum(k0 * k0 + k1 * k1 + kr * kr); rs = rsqrtf(ss * (1.f / 192.f) + EPSN);
      k0 = k0 * rs * wk0; k1 = k1 * rs * wk1; float k2 = kr * rs * wk2; if (lat) k2 = rope_lane(k2, lane, t, ROPE);
      bf16_t* ko = Ka + (size_t)r * 768 + h * 192; ko[lane] = f2bf(k0); ko[64 + lane] = f2bf(k1); ko[128 + lane] = f2bf(k2);
      bf16_t* vo = Va + (size_t)r * 512 + h * 128; vo[lane] = f2bf(v0); vo[64 + lane] = f2bf(v1);
    }
    };
  const int stride = gridDim.x * 8;
  for (int r = blockIdx.x * 8 + wid; r < T_TOK; r += 2 * stride) { do_row(r); if (r + stride < T_TOK) do_row(r + stride); }
}
__device__ __forceinline__ void diff_prep(bf16_t* __restrict__ DQK, const float* __restrict__ wq, const float* __restrict__ wk, const float* __restrict__ ROPE) {
  const int tid = tid_(); const int wid = tid >> 6, lane = tid & 63; const float w_q = wq[lane], w_k = wk[lane];
  const int stride = gridDim.x * 8;
  for (int r0 = blockIdx.x * 8 + wid; r0 < T_TOK; r0 += 2 * stride) {
    const int r1 = r0 + stride; const bool has1 = r1 < T_TOK;
    bf16_t* p0 = DQK + (size_t)r0 * 1024; bf16_t* p1 = DQK + (size_t)(has1 ? r1 : r0) * 1024;
    float x0[16], x1[16];
#pragma unroll
    for (int g = 0; g < 16; ++g) { x0[g] = bf2f(p0[g * 64 + lane]); x1[g] = bf2f(p1[g * 64 + lane]); }
#pragma unroll
    for (int g = 0; g < 16; ++g) {
      const float s0 = wave_sum(x0[g] * x0[g]), s1 = wave_sum(x1[g] * x1[g]);
      float y0 = x0[g] * rsqrtf(s0 * (1.f / 64.f) + EPSN) * (g < 8 ? w_q : w_k), y1 = x1[g] * rsqrtf(s1 * (1.f / 64.f) + EPSN) * (g < 8 ? w_q : w_k);
      if (r0 >= NCTX) y0 = rope_lane(y0, lane, r0 - NCTX, ROPE);
      if (r1 >= NCTX) y1 = rope_lane(y1, lane, r1 - NCTX, ROPE);
      p0[g * 64 + lane] = f2bf(y0); if (has1) p1[g * 64 + lane] = f2bf(y1);
    }
  }
}
__device__ __forceinline__ void rec_combine(const bf16_t* __restrict__ OF, const bf16_t* __restrict__ OBk, const bf16_t* __restrict__ gate, const float* __restrict__ nw, bf16_t* __restrict__ Y, int coff) {
  const int tid = tid_(); const int wid = tid >> 6, lane = tid & 63; const float w0 = nw[lane], w1 = nw[64 + lane];
  const int stride = gridDim.x * 8;
  for (int r0 = blockIdx.x * 8 + wid; r0 < T_TOK; r0 += 2 * stride)
#pragma unroll
  for (int rr = 0; rr < 2; ++rr) { const int r = r0 + rr * stride; if (r >= T_TOK) break;
#pragma unroll
    for (int h = 0; h < 4; ++h) { const size_t b = (size_t)r * 512 + h * 128 + lane;
      const float a0 = bf2f(OF[b]) + bf2f(OBk[b]), a1 = bf2f(OF[b + 64]) + bf2f(OBk[b + 64]);
      const float ss = wave_sum(a0 * a0 + a1 * a1); const float rs = rsqrtf(ss * (1.f / 128.f) + EPSN);
      bf16_t* yo = Y + (size_t)r * DM + coff + h * 128 + lane; yo[0] = f2bf(a0 * rs * w0 * bf2f(gate[b])); yo[64] = f2bf(a1 * rs * w1 * bf2f(gate[b + 64])); }
  }
}
__device__ __forceinline__ void diff_combine(const bf16_t* __restrict__ OD, const float* __restrict__ subln, float lam, float one_m_li, bf16_t* __restrict__ Y) {
  const int tid = tid_(); const int wid = tid >> 6, lane = tid & 63; const float w0 = subln[lane] * one_m_li, w1 = subln[64 + lane] * one_m_li;
  for (int r = blockIdx.x * 8 + wid; r < T_TOK; r += gridDim.x * 8) {
#pragma unroll
    for (int h = 0; h < 4; ++h) { const bf16_t* o1 = OD + (size_t)r * 1024 + h * 256 + lane; const bf16_t* o2 = o1 + 128;
      const float a0 = bf2f(o1[0]) - lam * bf2f(o2[0]), a1 = bf2f(o1[64]) - lam * bf2f(o2[64]);
      const float ss = wave_sum(a0 * a0 + a1 * a1); const float rs = rsqrtf(ss * (1.f / 128.f) + EPSN);
      bf16_t* yo = Y + (size_t)r * DM + h * 128 + lane; yo[0] = f2bf(a0 * rs * w0); yo[64] = f2bf(a1 * rs * w1); }
  }
}

__device__ __forceinline__ int rowmap(int d, int p) { return d == 0 ? p : (p < NCTX ? (NCTX - 1 - p) : (T_TOK + NCTX - 1 - p)); }
#define WAVE_LDS_SYNC() do { __builtin_amdgcn_fence(__ATOMIC_RELEASE, "workgroup"); __builtin_amdgcn_wave_barrier(); __builtin_amdgcn_fence(__ATOMIC_ACQUIRE, "workgroup"); } while (0)
template <int KD, int PASS>
__device__ __forceinline__ void rec_pass(const float* __restrict__ Ag, const float* __restrict__ Bg, const bf16_t* __restrict__ Vg, float* __restrict__ Sbuf, float* __restrict__ DL,
                                         bf16_t* __restrict__ OUT, const float* __restrict__ rt_decay_j, char* lds) {
  constexpr bool HG = (KD == 128); constexpr int KH = KD / 2, NB = 10, C4 = KH / 4, RPL = 64 / C4, NLD = (NB + RPL - 1) / RPL;
  constexpr int ldA = HG ? 1024 : 256, ldB = HG ? 512 : 256;
  constexpr int WSZ = 2 * NB * KH + NB * 64;
  const int tid = tid_(); const int wid = __builtin_amdgcn_readfirstlane(tid >> 6), lane = tid & 63;
  float* sA = (float*)lds + wid * WSZ; float* sB = sA + NB * KH; float* sV = sB + NB * KH;
  float* sR = (float*)lds + 8 * WSZ + (wid >> 1) * (2 * NB * 64);
  const int lrow = lane / C4, lc4 = lane % C4;
  for (int it = blockIdx.x * 8 + wid; it < NSC * 32; it += gridDim.x * 8) {
    const int kh = it & 1, vh = (it >> 1) & 1, d = (it >> 2) & 1, h = (it >> 3) & 3, sc = it >> 5, hd = h * 2 + d;
    const float* Abase = Ag + (HG ? (d * 512 + h * 128) : (h * 64)) + kh * KH;
    const float* Bbase = Bg + (HG ? (h * 128) : (h * 64)) + kh * KH;
    const bf16_t* Vbase = Vg + h * 128 + vh * 64 + lane;
    float gam = 0.f; if (!HG) gam = sigmoidf_(rt_decay_j[d * 4 + h]);
    f32x2 S2[KH / 2];
    float* Sg = Sbuf + ((size_t)(sc * 8 + hd) * KD + kh * KH) * 128 + vh * 64 + lane;
    if (PASS == 1) {
#pragma unroll
      for (int k = 0; k < KH / 2; ++k) S2[k] = (f32x2){0.f, 0.f};
    } else {
#pragma unroll
      for (int k = 0; k < KH / 2; ++k) S2[k] = (f32x2){Sg[(size_t)(2 * k) * 128], Sg[(size_t)(2 * k + 1) * 128]};
    }
    const f32x2 gam2 = {gam, gam};
    float dp = 1.f;
    const int p0 = sc * LSC;
    f32x4 la[NLD], lb[NLD]; float lv[NB];
#define REC_LOAD(pb) do { _Pragma("unroll") for (int jj = 0; jj < NLD; ++jj) { const int lr = jj * RPL + lrow; if (lr < NB) { const int rr = rowmap(d, (pb) + lr); \
        la[jj] = *(const f32x4*)(Abase + (size_t)rr * ldA + lc4 * 4); if (PASS == 3) lb[jj] = *(const f32x4*)(Bbase + (size_t)rr * ldB + lc4 * 4); } } \
      _Pragma("unroll") for (int i = 0; i < NB; ++i) lv[i] = bf2f(Vbase[(size_t)rowmap(d, (pb) + i) * 512]); } while (0)
    REC_LOAD(p0);
    for (int bt = 0; bt < LSC / NB; ++bt) {
      const int pb = p0 + bt * NB;
#pragma unroll
      for (int i = 0; i < NB; ++i) sV[i * 64 + lane] = lv[i];
#pragma unroll
      for (int jj = 0; jj < NLD; ++jj) { const int lr = jj * RPL + lrow; if (lr < NB) { *(f32x4*)(sA + lr * KH + lc4 * 4) = la[jj]; if (PASS == 3) *(f32x4*)(sB + lr * KH + lc4 * 4) = lb[jj]; } }
      WAVE_LDS_SYNC();
      if (bt + 1 < LSC / NB) REC_LOAD(pb + NB);
      {
        constexpr int NG = KH / 16;
        f32x4 ca[4], cb[4], na[4], nb[4];
#define LOADG(A_, B_, i_, g_) do { _Pragma("unroll") for (int q_ = 0; q_ < 4; ++q_) { A_[q_] = *(const f32x4*)(sA + (i_) * KH + (g_) * 16 + q_ * 4); \
          if (PASS == 3) B_[q_] = *(const f32x4*)(sB + (i_) * KH + (g_) * 16 + q_ * 4); } } while (0)
#define COMPG(A_, B_, g_) do { _Pragma("unroll") for (int q_ = 0; q_ < 4; ++q_) _Pragma("unroll") for (int e_ = 0; e_ < 2; ++e_) { const int kk_ = (g_) * 8 + q_ * 2 + e_; \
          const f32x2 a2 = {A_[q_][2 * e_], A_[q_][2 * e_ + 1]}; f32x2 s2 = S2[kk_]; \
          if (HG) s2 = a2 * (s2 - vv) + vv; else s2 = gam2 * s2 + a2 * vv; S2[kk_] = s2; \
          if (PASS == 3) { const f32x2 b2 = {B_[q_][2 * e_], B_[q_][2 * e_ + 1]}; if (e_ == 0) o2a += b2 * s2; else o2b += b2 * s2; } } } while (0)
        LOADG(ca, cb, 0, 0);
#pragma unroll 1
        for (int i = 0; i < NB; ++i) {
          const float v = sV[i * 64 + lane]; const f32x2 vv = {v, v}; f32x2 o2a = {0.f, 0.f}, o2b = {0.f, 0.f};
          if (HG && PASS == 1) dp *= sA[i * KH + lane];
#pragma unroll
          for (int g = 0; g < NG; g += 2) {
            LOADG(na, nb, i, g + 1); COMPG(ca, cb, g);
            if (g + 2 < NG) LOADG(ca, cb, i, g + 2); else LOADG(ca, cb, i + 1, 0);
            COMPG(na, nb, g + 1);
          }
          if (PASS == 3) { const f32x2 o2 = o2a + o2b; sR[(kh * NB + i) * 64 + lane] = o2[0] + o2[1]; }
        }
#undef LOADG
#undef COMPG
      }
      if (PASS == 3) {
        __syncthreads();
        if (kh == 0) {
#pragma unroll
          for (int i = 0; i < NB; ++i) OUT[(size_t)d * T_TOK * 512 + (size_t)rowmap(d, pb + i) * 512 + h * 128 + vh * 64 + lane] = f2bf(sR[i * 64 + lane] + sR[(NB + i) * 64 + lane]);
        }
        __syncthreads();
      } else { WAVE_LDS_SYNC(); }
    }
#undef REC_LOAD
    if (PASS == 1) {
#pragma unroll
      for (int k = 0; k < KH / 2; ++k) { Sg[(size_t)(2 * k) * 128] = S2[k][0]; Sg[(size_t)(2 * k + 1) * 128] = S2[k][1]; }
      if (HG && vh == 0) DL[(size_t)(sc * 8 + hd) * 128 + kh * 64 + lane] = dp;
    }
  }
}

#define LDS_BARRIER() do { asm volatile("s_waitcnt lgkmcnt(0)" ::: "memory"); __builtin_amdgcn_s_barrier(); asm volatile("" ::: "memory"); } while (0)
typedef __bf16 bf16x2_t __attribute__((ext_vector_type(2)));
__device__ __forceinline__ unsigned cvt2(float lo, float hi) { const f32x2 v = {lo, hi}; const bf16x2_t r = __builtin_convertvector(v, bf16x2_t); return __builtin_bit_cast(unsigned, r); }
__device__ __forceinline__ bf16_t f2bf2(float f) { return (bf16_t)(cvt2(f, 0.f) & 0xffffu); }
__device__ __forceinline__ bf16x8 mk8(u32x2 lo, u32x2 hi) { u32x4 w = {lo.x, lo.y, hi.x, hi.y}; return *reinterpret_cast<bf16x8*>(&w); }
template <int PASS>
__device__ __forceinline__ void hg_mfma_pass(const float* __restrict__ Fg, const float* __restrict__ Qg, const bf16_t* __restrict__ Vg, float* __restrict__ Sbuf, float* __restrict__ DL,
                                             bf16_t* __restrict__ OUT, char* lds) {
  constexpr int CH = 16, NCH = (LSC + CH - 1) / CH, QROW = 272;
  const int tid = tid_(); const int hb = tid >> 8, th_ = tid & 255, k = th_ & 127, th = th_ >> 7, lane = tid & 63, w = (tid >> 6) & 3, r16 = lane & 15, fq = lane >> 4;
  char* base = lds + hb * 32768;
  float* sSum = (float*)base;
  float* sD = (float*)(base + 1024);
  char* sQ = base + 2048;
  char* sK = sQ + 16 * QROW;
  bf16_t* sKT = (bf16_t*)(sK + 16 * QROW);
  bf16_t* sVT = sKT + 128 * 16;
  for (int it = blockIdx.x * 2 + hb; it < NSC * 8; it += gridDim.x * 2) {
    const int sc = it >> 3, hd = it & 7, h = hd >> 1, d = hd & 1;
    const float* Fb = Fg + d * 512 + h * 128 + k; const float* Qb = Qg + h * 128 + k; const bf16_t* Vb = Vg + h * 128 + k;
    f32x4 S[8][2];
    float* Sg = Sbuf + ((size_t)(sc * 8 + hd) * 128) * 128 + w * 32 + r16;
#pragma unroll
    for (int kt = 0; kt < 8; ++kt)
#pragma unroll
      for (int vt = 0; vt < 2; ++vt)
#pragma unroll
        for (int j = 0; j < 4; ++j) S[kt][vt][j] = (PASS == 1) ? 0.f : Sg[(size_t)(16 * kt + 4 * fq + j) * 128 + vt * 16];
    float dprod = 1.f;
    const int p0 = sc * LSC;
    float lf[8], lq[8], lv[8];
#define HG_LOAD(c_) do { _Pragma("unroll") for (int i = 0; i < 8; ++i) { const int tt = (c_) * CH + 8 * th + i; \
      if (tt < LSC) { const int rr = rowmap(d, p0 + tt); lf[i] = Fb[(size_t)rr * 1024]; lv[i] = bf2f(Vb[(size_t)rr * 512]); if (PASS == 3) lq[i] = Qb[(size_t)rr * 512]; else lq[i] = 0.f; } \
      else { lf[i] = 1.f; lv[i] = 0.f; lq[i] = 0.f; } } } while (0)
    HG_LOAD(0);
    for (int c = 0; c < NCH; ++c) {
      float f8[8], q8[8], v8[8], b8[8];
#pragma unroll
      for (int i = 0; i < 8; ++i) { f8[i] = lf[i]; q8[i] = lq[i]; v8[i] = lv[i]; }
      float run = 0.f;
#pragma unroll
      for (int i = 0; i < 8; ++i) { run += fmaxf(__logf(f8[i]), -60.f); b8[i] = run; }
      sSum[th * 128 + k] = run;
      LDS_BARRIER();
      const float s0 = sSum[k], s1 = sSum[128 + k], blast = s0 + s1, boff = th ? s0 : 0.f;
      unsigned kh[4], vv[4];
#pragma unroll
      for (int i = 0; i < 8; i += 2) {
        float qt[2], kt_[2], khh[2];
#pragma unroll
        for (int e = 0; e < 2; ++e) { const float b = b8[i + e] + boff, omf = 1.f - f8[i + e];
          qt[e] = q8[i + e] * __expf(b); kt_[e] = omf * __expf(fminf(-b, 85.f)); khh[e] = omf * __expf(blast - b); }
        if (PASS == 3) { *(bf16_t*)(sQ + (8 * th + i) * QROW + k * 2) = f2bf2(qt[0]); *(bf16_t*)(sQ + (8 * th + i + 1) * QROW + k * 2) = f2bf2(qt[1]);
                         *(bf16_t*)(sK + (8 * th + i) * QROW + k * 2) = f2bf2(kt_[0]); *(bf16_t*)(sK + (8 * th + i + 1) * QROW + k * 2) = f2bf2(kt_[1]); }
        kh[i >> 1] = cvt2(khh[0], khh[1]); vv[i >> 1] = cvt2(v8[i], v8[i + 1]);
      }
      *(u32x4*)(sKT + k * 16 + 8 * th) = (u32x4){kh[0], kh[1], kh[2], kh[3]};
      *(u32x4*)(sVT + k * 16 + 8 * th) = (u32x4){vv[0], vv[1], vv[2], vv[3]};
      if (th == 0) { const float dk = __expf(blast); sD[k] = dk; dprod *= dk; }
      if (c + 1 < NCH) HG_LOAD(c + 1);
      LDS_BARRIER();
      bf16x8 VT[2];
#pragma unroll
      for (int vt = 0; vt < 2; ++vt) VT[vt] = mk8(*(const u32x2*)(sVT + (w * 32 + vt * 16 + r16) * 16 + 4 * fq), (u32x2){0u, 0u});
      if (PASS == 3) {
        bf16x8 Qp[4]; f32x4 A = {0.f, 0.f, 0.f, 0.f};
#pragma unroll
        for (int j = 0; j < 4; ++j) {
          const char* qa = sQ + r16 * QROW + (32 * j + 4 * fq) * 2; const char* ka = sK + r16 * QROW + (32 * j + 4 * fq) * 2;
          Qp[j] = mk8(*(const u32x2*)qa, *(const u32x2*)(qa + 32));
          const bf16x8 Kp = mk8(*(const u32x2*)ka, *(const u32x2*)(ka + 32));
          A = __builtin_amdgcn_mfma_f32_16x16x32_bf16(Kp, Qp[j], A, 0, 0, 0);
        }
#pragma unroll
        for (int jj = 0; jj < 4; ++jj) A[jj] = (4 * fq + jj <= r16) ? A[jj] : 0.f;
        const bf16x8 Af = mk8((u32x2){cvt2(A[0], A[1]), cvt2(A[2], A[3])}, (u32x2){0u, 0u});
#pragma unroll
        for (int vt = 0; vt < 2; ++vt) {
          f32x4 O = {0.f, 0.f, 0.f, 0.f};
          O = __builtin_amdgcn_mfma_f32_16x16x32_bf16(Af, VT[vt], O, 0, 0, 0);
#pragma unroll
          for (int j = 0; j < 4; ++j) {
            const bf16x8 Sf = mk8((u32x2){cvt2(S[2 * j][vt][0], S[2 * j][vt][1]), cvt2(S[2 * j][vt][2], S[2 * j][vt][3])},
                                  (u32x2){cvt2(S[2 * j + 1][vt][0], S[2 * j + 1][vt][1]), cvt2(S[2 * j + 1][vt][2], S[2 * j + 1][vt][3])});
            O = __builtin_amdgcn_mfma_f32_16x16x32_bf16(Qp[j], Sf, O, 0, 0, 0);
          }
#pragma unroll
          for (int jj = 0; jj < 4; ++jj) { const int tt = c * CH + 4 * fq + jj;
            if (tt < LSC) OUT[(size_t)d * T_TOK * 512 + (size_t)rowmap(d, p0 + tt) * 512 + h * 128 + w * 32 + vt * 16 + r16] = f2bf2(O[jj]); }
        }
      }
#pragma unroll
      for (int kt = 0; kt < 8; ++kt) {
        const bf16x8 KTf = mk8(*(const u32x2*)(sKT + (16 * kt + r16) * 16 + 4 * fq), (u32x2){0u, 0u});
        const f32x4 dk4 = *(const f32x4*)(sD + 16 * kt + 4 * fq);
#pragma unroll
        for (int vt = 0; vt < 2; ++vt) S[kt][vt] = __builtin_amdgcn_mfma_f32_16x16x32_bf16(KTf, VT[vt], S[kt][vt] * dk4, 0, 0, 0);
      }
    }
#undef HG_LOAD
    if (PASS == 1) {
#pragma unroll
      for (int kt = 0; kt < 8; ++kt)
#pragma unroll
        for (int vt = 0; vt < 2; ++vt)
#pragma unroll
          for (int j = 0; j < 4; ++j) Sg[(size_t)(16 * kt + 4 * fq + j) * 128 + vt * 16] = S[kt][vt][j];
      if (th == 0) DL[(size_t)(sc * 8 + hd) * 128 + k] = dprod;
    }
    __syncthreads();
  }
}


template <int PASS>
__device__ __forceinline__ void rt_mfma_pass(const float* __restrict__ Kg, const float* __restrict__ Qg, const bf16_t* __restrict__ Vg, float* __restrict__ Sbuf,
                                             bf16_t* __restrict__ OUT, const float* __restrict__ rt_decay_j, char* lds) {
  constexpr int CH = 16, NCH = (LSC + CH - 1) / CH, QROW = 144;
  const int tid = tid_(); const int hb = tid >> 8, th_ = tid & 255, kq = th_ & 63, tq = th_ >> 6, vcol = th_ & 127, th = th_ >> 7, lane = tid & 63, w = (tid >> 6) & 3, r16 = lane & 15, fq = lane >> 4;
  char* base = lds + hb * 32768;
  char* sQ = base;
  char* sK = sQ + 16 * QROW;
  bf16_t* sKT = (bf16_t*)(sK + 16 * QROW);
  bf16_t* sVT = sKT + 64 * 16;
  for (int it = blockIdx.x * 2 + hb; it < NSC * 8; it += gridDim.x * 2) {
    const int sc = it >> 3, hd = it & 7, h = hd >> 1, d = hd & 1;
    const float lg = -log1pf(expf(-rt_decay_j[d * 4 + h]));
    const float* Kb = Kg + h * 64 + kq; const float* Qb = Qg + h * 64 + kq; const bf16_t* Vb = Vg + h * 128 + vcol;
    f32x4 S[4][2];
    float* Sg = Sbuf + ((size_t)(sc * 8 + hd) * 64) * 128 + w * 32 + r16;
#pragma unroll
    for (int kt = 0; kt < 4; ++kt)
#pragma unroll
      for (int vt = 0; vt < 2; ++vt)
#pragma unroll
        for (int j = 0; j < 4; ++j) S[kt][vt][j] = (PASS == 1) ? 0.f : Sg[(size_t)(16 * kt + 4 * fq + j) * 128 + vt * 16];
    const int p0 = sc * LSC;
    float lk[4], lq[4], lv[8];
#define RT_LOAD(c_) do { _Pragma("unroll") for (int i = 0; i < 4; ++i) { const int tt = (c_) * CH + 4 * tq + i; \
      if (tt < LSC) { const int rr = rowmap(d, p0 + tt); lk[i] = Kb[(size_t)rr * 256]; if (PASS == 3) lq[i] = Qb[(size_t)rr * 256]; else lq[i] = 0.f; } else { lk[i] = 0.f; lq[i] = 0.f; } } \
      _Pragma("unroll") for (int i = 0; i < 8; ++i) { const int tt = (c_) * CH + 8 * th + i; lv[i] = (tt < LSC) ? bf2f(Vb[(size_t)rowmap(d, p0 + tt) * 512]) : 0.f; } } while (0)
    RT_LOAD(0);
    for (int c = 0; c < NCH; ++c) {
      const int nvalid = (LSC - c * CH) < CH ? (LSC - c * CH) : CH;
      const float blast = (float)nvalid * lg, dk = __expf(blast);
      float k4[4], q4[4], v8[8];
#pragma unroll
      for (int i = 0; i < 4; ++i) { k4[i] = lk[i]; q4[i] = lq[i]; }
#pragma unroll
      for (int i = 0; i < 8; ++i) v8[i] = lv[i];
      LDS_BARRIER();
      float khh[4];
#pragma unroll
      for (int i = 0; i < 4; ++i) { const int tl = 4 * tq + i; const float b = (float)((tl + 1) < nvalid ? (tl + 1) : nvalid) * lg;
        if (PASS == 3) { *(bf16_t*)(sQ + tl * QROW + kq * 2) = f2bf2(q4[i] * __expf(b)); *(bf16_t*)(sK + tl * QROW + kq * 2) = f2bf2(k4[i] * __expf(-b)); }
        khh[i] = k4[i] * __expf(blast - b); }
      *(u32x2*)(sKT + kq * 16 + 4 * tq) = (u32x2){cvt2(khh[0], khh[1]), cvt2(khh[2], khh[3])};
      *(u32x4*)(sVT + vcol * 16 + 8 * th) = (u32x4){cvt2(v8[0], v8[1]), cvt2(v8[2], v8[3]), cvt2(v8[4], v8[5]), cvt2(v8[6], v8[7])};
      if (c + 1 < NCH) RT_LOAD(c + 1);
      LDS_BARRIER();
      bf16x8 VT[2];
#pragma unroll
      for (int vt = 0; vt < 2; ++vt) VT[vt] = mk8(*(const u32x2*)(sVT + (w * 32 + vt * 16 + r16) * 16 + 4 * fq), (u32x2){0u, 0u});
      if (PASS == 3) {
        bf16x8 Qp[2]; f32x4 A = {0.f, 0.f, 0.f, 0.f};
#pragma unroll
        for (int j = 0; j < 2; ++j) {
          const char* qa = sQ + r16 * QROW + (32 * j + 4 * fq) * 2; const char* ka = sK + r16 * QROW + (32 * j + 4 * fq) * 2;
          Qp[j] = mk8(*(const u32x2*)qa, *(const u32x2*)(qa + 32));
          const bf16x8 Kp = mk8(*(const u32x2*)ka, *(const u32x2*)(ka + 32));
          A = __builtin_amdgcn_mfma_f32_16x16x32_bf16(Kp, Qp[j], A, 0, 0, 0);
        }
#pragma unroll
        for (int jj = 0; jj < 4; ++jj) A[jj] = (4 * fq + jj <= r16) ? A[jj] : 0.f;
        const bf16x8 Af = mk8((u32x2){cvt2(A[0], A[1]), cvt2(A[2], A[3])}, (u32x2){0u, 0u});
#pragma unroll
        for (int vt = 0; vt < 2; ++vt) {
          f32x4 O = {0.f, 0.f, 0.f, 0.f};
          O = __builtin_amdgcn_mfma_f32_16x16x32_bf16(Af, VT[vt], O, 0, 0, 0);
#pragma unroll
          for (int j = 0; j < 2; ++j) {
            const bf16x8 Sf = mk8((u32x2){cvt2(S[2 * j][vt][0], S[2 * j][vt][1]), cvt2(S[2 * j][vt][2], S[2 * j][vt][3])},
                                  (u32x2){cvt2(S[2 * j + 1][vt][0], S[2 * j + 1][vt][1]), cvt2(S[2 * j + 1][vt][2], S[2 * j + 1][vt][3])});
            O = __builtin_amdgcn_mfma_f32_16x16x32_bf16(Qp[j], Sf, O, 0, 0, 0);
          }
#pragma unroll
          for (int jj = 0; jj < 4; ++jj) { const int tt = c * CH + 4 * fq + jj;
            if (tt < LSC) OUT[(size_t)d * T_TOK * 512 + (size_t)rowmap(d, p0 + tt) * 512 + h * 128 + w * 32 + vt * 16 + r16] = f2bf2(O[jj]); }
        }
      }
#pragma unroll
      for (int kt = 0; kt < 4; ++kt) {
        const bf16x8 KTf = mk8(*(const u32x2*)(sKT + (16 * kt + r16) * 16 + 4 * fq), (u32x2){0u, 0u});
#pragma unroll
        for (int vt = 0; vt < 2; ++vt) S[kt][vt] = __builtin_amdgcn_mfma_f32_16x16x32_bf16(KTf, VT[vt], S[kt][vt] * dk, 0, 0, 0);
      }
    }
#undef RT_LOAD
    if (PASS == 1) {
#pragma unroll
      for (int kt = 0; kt < 4; ++kt)
#pragma unroll
        for (int vt = 0; vt < 2; ++vt)
#pragma unroll
          for (int j = 0; j < 4; ++j) Sg[(size_t)(16 * kt + 4 * fq + j) * 128 + vt * 16] = S[kt][vt][j];
    }
    __syncthreads();
  }
}

template <int KD>
__device__ __forceinline__ void rec_scan(float* __restrict__ Sbuf, const float* __restrict__ DL, const float* __restrict__ rt_decay_j) {
  constexpr bool HG = (KD == 128); constexpr int PER = KD * 128;
  for (int idx = blockIdx.x * 512 + tid_(); idx < 8 * PER; idx += gridDim.x * 512) {
    const int hd = idx / PER, k = (idx / 128) % KD; float run = 0.f; float dsc = 0.f;
    if (!HG) { const float lgm = -log1pf(expf(-rt_decay_j[(hd & 1) * 4 + (hd >> 1)])); dsc = __expf((float)LSC * lgm); }
    float* p = Sbuf + (size_t)hd * PER + (idx % PER);
    constexpr int SB = 32;
    for (int s0 = 0; s0 < NSC; s0 += SB) {
      float loc[SB], dec[SB];
#pragma unroll
      for (int j = 0; j < SB; ++j) { loc[j] = p[(size_t)(s0 + j) * 8 * PER]; dec[j] = HG ? DL[(size_t)((s0 + j) * 8 + hd) * 128 + k] : dsc; }
#pragma unroll
      for (int j = 0; j < SB; ++j) { p[(size_t)(s0 + j) * 8 * PER] = run; run = dec[j] * run + loc[j]; }
    }
  }
}

template <class PT> __device__ __forceinline__ void setup_phase(const PT& P, float* X, float* MOD, float* ROPE, float* LB, float* SCAL, char* lds) {
  const int tid = tid_(), wid = tid >> 6, lane = tid & 63;
  { float* sv = (float*)lds; float* red = sv + 2048;
    for (int i = tid; i < 1024; i += 512) { sv[i] = siluf_(P.c[i]); sv[1024 + i] = siluf_(P.c_ctx[i]); }
    __syncthreads();
    for (int item = blockIdx.x; item < 4 * 96; item += gridDim.x) {
      const int l = item / 96, n = (item % 96) * 64 + lane; float a0 = 0.f, a1 = 0.f;
      const float* w = P.ada_w + ((size_t)l * 1024 + wid * 128) * 6144 + n;
#pragma unroll 8
      for (int k = 0; k < 128; ++k) { const float wv = w[(size_t)k * 6144]; a0 = fmaf(sv[wid * 128 + k], wv, a0); a1 = fmaf(sv[1024 + wid * 128 + k], wv, a1); }
      red[(wid * 2 + 0) * 64 + lane] = a0; red[(wid * 2 + 1) * 64 + lane] = a1;
      __syncthreads();
      if (wid < 2) { float s = P.ada_b[l * 6144 + n];
#pragma unroll
        for (int w8 = 0; w8 < 8; ++w8) s += red[(w8 * 2 + wid) * 64 + lane];
        MOD[((size_t)l * 2 + wid) * 6144 + n] = s; }
      __syncthreads();
    }
  }
  if (blockIdx.x == gridDim.x - 1) {
    for (int i = tid; i < 256 * 16; i += 512) { const int pos = i >> 4, f = i & 15; const float inv = powf(10000.f, -(float)f / 16.f); float s, c; sincosf((float)pos * inv, &s, &c); ROPE[i * 2] = c; ROPE[i * 2 + 1] = s; }
    for (int i = tid; i < 1024; i += 512) { const float b0 = P.hg_lb[i], b1 = P.hg_lb[1024 + i]; LB[i] = 0.f; LB[1024 + i] = 1.f / (1.f + expf(b0 - b1)); }
    if (tid < 2) { const float* lm = P.da_lambda + tid * 256; float s01 = 0.f, s23 = 0.f; for (int i = 0; i < 64; ++i) { s01 += lm[i] * lm[64 + i]; s23 += lm[128 + i] * lm[192 + i]; }
      const float li = 0.8f - 0.6f * expf(-0.3f * (float)(2 * tid + 1)); SCAL[tid * 2] = expf(s01) - expf(s23) + li; SCAL[tid * 2 + 1] = 1.f - li; }
  }
}

#define XB_TMO      128
#define XB_XCNT(j)  (256  + 64 * (j))
#define XB_XSUB(j)  (1280 + 64 * (j))
#define XB_XGEN(j)  (2304 + 64 * (j))
#define XB_TOP      3328
#define XB_TOPGEN   3392
#define XCD_BAR_WORDS 3456
#define XB_SPIN_CAP (1u << 22)
__device__ __forceinline__ unsigned xb_ld(unsigned* p)              { return __hip_atomic_load(p, __ATOMIC_RELAXED, __HIP_MEMORY_SCOPE_AGENT); }
__device__ __forceinline__ unsigned xb_add(unsigned* p, unsigned v) { return __hip_atomic_fetch_add(p, v, __ATOMIC_RELAXED, __HIP_MEMORY_SCOPE_AGENT); }
__device__ __forceinline__ unsigned xb_xcc_id() { return (unsigned)__builtin_amdgcn_s_getreg((3 << 11) | 20) & 0xFu; }
#define XB_SPIN(cond, bar) do { unsigned _sp = 0; while (cond) { __builtin_amdgcn_s_sleep(1); \
    if ((++_sp & 255u) == 0u) { if (xb_ld(&(bar)[XB_TMO])) break; if (_sp > XB_SPIN_CAP) { atomicAdd(&(bar)[XB_TMO], 1u); break; } } } } while (0)
__device__ __forceinline__ void xcd_barrier_complete(unsigned* bar, unsigned x, unsigned& nloc, unsigned& nx) {
  const unsigned G = gridDim.x;
  unsigned sum, cnt, mine, sp = 0u;
  for (;;) {
    sum = 0u; cnt = 0u; mine = 0u;
#pragma unroll
    for (unsigned j = 0; j < 16; ++j) { const unsigned c = xb_ld(&bar[XB_XCNT(j)]); sum += c; cnt += (c > 0u) ? 1u : 0u; mine = (j == x) ? c : mine; }
    if (sum == G) break;
    __builtin_amdgcn_s_sleep(1);
    if ((++sp & 255u) == 0u) { if (xb_ld(&bar[XB_TMO])) break; if (sp > XB_SPIN_CAP) { atomicAdd(&bar[XB_TMO], 1u); break; } }
  }
  nloc = mine > 0u ? mine : 1u; nx = cnt > 0u ? cnt : 1u;
}
__device__ __forceinline__ void grid_sync(unsigned* bar, volatile LAS unsigned* st) {
  asm volatile("s_waitcnt vmcnt(0)" ::: "memory");
  __syncthreads();
  if (threadIdx.x == 0) {
    __builtin_amdgcn_s_waitcnt(0);
    const unsigned x = xb_xcc_id();
    unsigned nloc = st[0], nx = st[1];
    if (nloc == 0u) { xcd_barrier_complete(bar, x, nloc, nx); st[0] = nloc; st[1] = nx; }
    const unsigned old = xb_add(&bar[XB_XSUB(x)], 1u);
    const unsigned gen = old / nloc;
    if (old + 1u == (gen + 1u) * nloc) {
      __builtin_amdgcn_fence(__ATOMIC_RELEASE, "agent");
      asm volatile("s_waitcnt vmcnt(0)" ::: "memory");
      const unsigned og = xb_add(&bar[XB_TOP], 1u);
      const unsigned tg = og / nx;
      if (og + 1u == (tg + 1u) * nx) xb_add(&bar[XB_TOPGEN], 1u);
      else XB_SPIN(xb_ld(&bar[XB_TOPGEN]) == tg, bar);
      __builtin_amdgcn_fence(__ATOMIC_ACQUIRE, "agent");
      xb_add(&bar[XB_XGEN(x)], 1u);
      asm volatile("s_waitcnt vmcnt(0)" ::: "memory");
    } else {
      XB_SPIN(xb_ld(&bar[XB_XGEN(x)]) == gen, bar);
      __builtin_amdgcn_fence(__ATOMIC_ACQUIRE, "agent");
      asm volatile("s_waitcnt vmcnt(0)" ::: "memory");
    }
  }
  __syncthreads();
}

typedef const Params __attribute__((address_space(4))) CParams;
__device__ __forceinline__ const CParams* get_params() {
  auto p = __builtin_amdgcn_kernarg_segment_ptr();
  asm volatile("" : "+s"(p)); return (const CParams*)p;
}
__global__ void __launch_bounds__(512) fwd_megakernel(Params Parg) {
  extern __shared__ __attribute__((aligned(16))) char shm[];
  cg::grid_group grid = cg::this_grid();
#define P (*get_params())
#define WS_ (P.ws)
#define X ((float*)(WS_ + OFF_X))
#define HB ((bf16_t*)(WS_ + OFF_HB))
#define Y ((bf16_t*)(WS_ + OFF_Y))
#define W (WS_ + OFF_W)
#define MOD ((float*)(WS_ + OFF_MOD))
#define ROPE ((float*)(WS_ + OFF_ROPE))
#define LB ((float*)(WS_ + OFF_LB))
#define SCAL ((float*)(WS_ + OFF_SCAL))
#define BAR ((unsigned*)(WS_ + OFF_BAR))
#define D (WS_ + OFF_D)
#define PART ((float*)(WS_ + OFF_PART))
#define GS() grid_sync(BAR, (volatile LAS unsigned*)xb_st)
#define Win ((bf16_t*)(W + W_IN))
#define Wo ((bf16_t*)(W + W_O))
#define W1 ((bf16_t*)(W + W_1))
#define W2 ((bf16_t*)(W + W_2))
#define Wuq ((bf16_t*)(W + W_UQ))
#define Wukv ((bf16_t*)(W + W_UKV))
#define OFb HB
#define OBb (HB + (size_t)T_TOK * 512)
  LAS unsigned char* glds = (LAS unsigned char*)shm;
  __shared__ __attribute__((aligned(16))) unsigned xb_st[4];
  if (threadIdx.x < 4) xb_st[threadIdx.x] = 0u;
  __syncthreads();
  if (threadIdx.x == 0) (void)xb_add(&BAR[XB_XCNT(xb_xcc_id())], 1u);

  for (int rep = 0; rep < REP_MISC; ++rep) { setup_phase(P, X, MOD, ROPE, LB, SCAL, shm); __syncthreads(); }
  if (P.out == nullptr) grid.sync();
  GS();

  for (int l = 0; l < 4; ++l) {
    const bool last = (l == 3), even = (l & 1) == 0; const int j = l >> 1; const int pm0 = last ? 1 : 0;
#define modL (MOD + (size_t)(l * 2 + 0) * 6144)
#define modC (MOD + (size_t)(l * 2 + 1) * 6144)
    for (int rep = 0; rep < REP_MISC; ++rep) {
      float* tile = (float*)shm;
      if (even) {
        conv_matrix(P.a_w_in + (size_t)j * 1024 * 3264, 1024, 3264, 3328, Win, nullptr, tile);
        conv_matrix(P.mla_w_uq + (size_t)j * 384 * 768, 384, 768, 768, Wuq, P.mla_q_norm + j * 384, tile);
        conv_matrix(P.mla_w_ukv + (size_t)j * 256 * 1024, 256, 1024, 1024, Wukv, P.mla_kv_norm + j * 256, tile);
      } else {
        conv_matrix(P.c_w_in + (size_t)j * 1024 * 3072, 1024, 3072, 3072, Win, nullptr, tile);
      }
      conv_matrix(P.w_o + (size_t)l * 1024 * 1024, 1024, 1024, 1024, Wo, nullptr, tile);
      conv_matrix(P.mlp_w1 + (size_t)l * 1024 * 4096, 1024, 4096, 4096, W1, nullptr, tile);
      conv_matrix(P.mlp_w2 + (size_t)l * 4096 * 1024, 4096, 1024, 1024, W2, nullptr, tile);
      norm_phase(X, HB, P.norm_w + (size_t)(l * 2 + 0) * 1024, modL, modC, 0, 1024, PART, l > 0 ? 8 : 0, l == 0 ? P.x : nullptr, l == 0 ? P.ctx : nullptr);
    }
    GS();
    pg8::StaticOrder SO;
    if (even) {
      float* QH = (float*)(D + DE_QH); float* F = (float*)(D + DE_F); bf16_t* VH = (bf16_t*)(D + DE_VH); bf16_t* G = (bf16_t*)(D + DE_G); bf16_t* CQ = (bf16_t*)(D + DE_CQ);
      float* Sb = (float*)(D + DE_S); float* DLb = (float*)(D + DE_DL);
      bf16_t* U = (bf16_t*)(D + DE_U); bf16_t* Qa = (bf16_t*)(D + DE_QA); bf16_t* Ka = (bf16_t*)(D + DE_KA); bf16_t* Va = (bf16_t*)(D + DE_VA);
      { pg8::Gemm g{HB, Win, T_TOK, 3328, 1024, 1024, 1024}; SO.init(T_TOK, 3328, gridDim.x, blockIdx.x, 0);
        EpiG1Even E{QH, F, VH, G, CQ, LB + j * 1024}; for (int rep = 0; rep < REP_GEMM; ++rep) pg8::gemm_phase(glds, g, SO, E); }
      GS();
      hg_mfma_pass<1>(F, QH, VH, Sb, DLb, nullptr, shm);
      GS();
      rec_scan<128>(Sb, DLb, nullptr);
      GS();
      hg_mfma_pass<3>(F, QH, VH, Sb, DLb, HB, shm);
      GS();
      rec_combine(OFb, OBb, G, P.hg_norm + j * 128, Y, 0);
      { pg8::Gemm g{CQ, Wuq, T_TOK, 768, 384, 768, 384}; SO.init(T_TOK, 768, gridDim.x, blockIdx.x, 0);
        EpiBf16Off E{U, 1792, 0}; pg8::gemm_phase(glds, g, SO, E); }
      { pg8::Gemm g{CQ + 384, Wukv, T_TOK, 1024, 256, 768, 256}; SO.init(T_TOK, 1024, gridDim.x, blockIdx.x, 0);
        EpiBf16Off E{U, 1792, 768}; pg8::gemm_phase(glds, g, SO, E); }
      GS();
      mla_prep(U, CQ, Qa, Ka, Va, P.mla_qk_q + j * 192, P.mla_qk_k + j * 192, ROPE);
      GS();
      { const int nlat = 64 * 4, nit = nlat + (last ? 0 : 4); const float scale = 0.07216878364870322f;
        for (int rep = 0; rep < REP_ATT; ++rep)
        for (int it = blockIdx.x; it < nit; it += gridDim.x) {
          if (it < nlat) { const int qb = it >> 2, h = it & 3; const size_t r0 = NCTX + (size_t)qb * 256;
            attn_body<12, 1, false>(Qa + r0 * 768 + h * 192, 768, Ka + h * 192, 768, Va + h * 128, 512, Y + r0 * DM + 512 + h * 128, DM, T_TOK, scale, shm); }
          else { const int h = it - nlat;
            attn_body<12, 1, false>(Qa + h * 192, 768, Ka + h * 192, 768, Va + h * 128, 512, Y + 512 + h * 128, DM, NCTX, scale, shm); } } }
      GS();
    } else {
      bf16_t* DQK = (bf16_t*)(D + DO_DQK); bf16_t* DV = (bf16_t*)(D + DO_DV); float* RQ = (float*)(D + DO_RQ); float* RK = (float*)(D + DO_RK);
      bf16_t* RV = (bf16_t*)(D + DO_RV); bf16_t* RG = (bf16_t*)(D + DO_RG); bf16_t* OD = (bf16_t*)(D + DO_OD); float* Sb = (float*)(D + DO_S);
      const float* rtd = P.rt_decay + j * 8;
      { pg8::Gemm g{HB, Win, T_TOK, 3072, 1024, 1024, 1024}; SO.init(T_TOK, 3072, gridDim.x, blockIdx.x, 0);
        EpiG1Odd E{DQK, DV, RQ, RK, RV, RG, ROPE}; for (int rep = 0; rep < REP_GEMM; ++rep) pg8::gemm_phase(glds, g, SO, E); }
      GS();
      rt_mfma_pass<1>(RK, RQ, RV, Sb, nullptr, rtd, shm);
      diff_prep(DQK, P.da_qk_q + j * 64, P.da_qk_k + j * 64, ROPE);
      GS();
      rec_scan<64>(Sb, nullptr, rtd);
      { const int nlat = 64 * 8, nit = nlat + (last ? 0 : 8);
        for (int rep = 0; rep < REP_ATT; ++rep)
        for (int it = blockIdx.x; it < nit; it += gridDim.x) {
          if (it < nlat) { const int qb = it >> 3, hs = it & 7; const size_t r0 = NCTX + (size_t)qb * 256;
            attn_body<4, 2, true>(DQK + r0 * 1024 + hs * 64, 1024, DQK + 512 + hs * 64, 1024, DV + (hs >> 1) * 128, 512, OD + r0 * 1024 + hs * 128, 1024, T_TOK, 0.125f, shm); }
          else { const int hs = it - nlat;
            attn_body<4, 2, true>(DQK + hs * 64, 1024, DQK + 512 + hs * 64, 1024, DV + (hs >> 1) * 128, 512, OD + hs * 128, 1024, NCTX, 0.125f, shm); } } }
      GS();
      rt_mfma_pass<3>(RK, RQ, RV, Sb, HB, rtd, shm);
      GS();
      diff_combine(OD, P.da_subln + j * 128, SCAL[j * 2], SCAL[j * 2 + 1], Y);
      rec_combine(OFb, OBb, RG, P.rt_norm + j * 128, Y, 512);
      GS();
    }
    if (!last) { pg8::Gemm g{Y, Wo, T_TOK, 1024, 256, 1024, 1024}; pg8::SplitKOrder SK; SK.init(1024, 4, 256, gridDim.x, blockIdx.x);
      EpiPartial E{PART, modC + 2048, 256}; pg8::gemm_phase(glds, g, SK, E); }
    { pg8::Gemm g{Y, Wo, T_TOK, 1024, 1024, 1024, 1024}; SO.init(T_TOK, 1024, gridDim.x, blockIdx.x, 1);
      EpiResid E{X, modL + 2048, modC + 2048, nullptr, l == 0 ? P.x : nullptr}; pg8::gemm_phase(glds, g, SO, E);
      if (REP_GEMM > 1) { EpiBf16Off E2{(bf16_t*)D, 1024, 0}; pg8::gemm_phase(glds, g, SO, E2); } }
    GS();
    for (int rep = 0; rep < REP_MISC; ++rep)
    norm_phase(X, HB, P.norm_w + (size_t)(l * 2 + 1) * 1024, modL, modC, 3072, 4096, PART, last ? 0 : 4, nullptr, l == 0 ? P.ctx : nullptr);
    GS();
    bf16_t* Hid = (bf16_t*)D;
    { pg8::Gemm g{HB, W1, T_TOK, 4096, 1024, 1024, 1024}; SO.init(T_TOK, 4096, gridDim.x, blockIdx.x, pm0);
      EpiSqRelu E{Hid, 4096}; for (int rep = 0; rep < REP_GEMM; ++rep) pg8::gemm_phase(glds, g, SO, E); }
    GS();
    if (!last) { pg8::Gemm g{Hid, W2, T_TOK, 1024, 512, 4096, 4096}; pg8::SplitKOrder SK; SK.init(1024, 8, 512, gridDim.x, blockIdx.x);
      EpiPartial E{PART, modC + 5120, 512}; pg8::gemm_phase(glds, g, SK, E); }
    { pg8::Gemm g{Hid, W2, T_TOK, 1024, 4096, 4096, 4096}; SO.init(T_TOK, 1024, gridDim.x, blockIdx.x, 1);
      EpiResid E{X, modL + 5120, modC + 5120, last ? P.out : nullptr, nullptr}; pg8::gemm_phase(glds, g, SO, E);
      if (REP_GEMM > 1) { EpiBf16Off E2{HB, 1024, 0}; pg8::gemm_phase(glds, g, SO, E2); } }
    if (!last) GS();
  }
#undef GS
#undef P
#undef X
#undef HB
#undef Y
#undef W
#undef MOD
#undef ROPE
#undef LB
#undef SCAL
#undef BAR
#undef D
#undef PART
#undef Win
#undef Wo
#undef W1
#undef W2
#undef Wuq
#undef Wukv
#undef OFb
#undef OBb
#undef modL
#undef modC
#undef WS_
}

extern "C" void kernel_launch(void* const* d_in, const int* in_sizes, int n_in, void* d_out, int out_size, void* d_ws, size_t ws_size, hipStream_t stream) {
  constexpr size_t kDynLds = 131072;
  static int grid_blocks = 0;
  if (!grid_blocks) {
    hipFuncSetAttribute((const void*)fwd_megakernel, hipFuncAttributeMaxDynamicSharedMemorySize, (int)kDynLds);
    int dev = 0, cus = 0, per_cu = 0;
    hipGetDevice(&dev);
    hipDeviceGetAttribute(&cus, hipDeviceAttributeMultiprocessorCount, dev);
    hipOccupancyMaxActiveBlocksPerMultiprocessor(&per_cu, fwd_megakernel, 512, kDynLds);
    if (per_cu < 1) per_cu = 1;
    grid_blocks = cus * 1;
    if (ws_size < WS_NEED) fprintf(stderr, "workspace too small: %zu < %zu\n", ws_size, (size_t)WS_NEED);
  }
  Params p; memset(&p, 0, sizeof(p));
  const float* const* in = (const float* const*)d_in;
  p.x = in[0]; p.c = in[1]; p.ctx = in[2]; p.c_ctx = in[3]; p.ada_w = in[4]; p.ada_b = in[5]; p.norm_w = in[6]; p.w_o = in[7]; p.mlp_w1 = in[8]; p.mlp_w2 = in[9];
  p.a_w_in = in[10]; p.hg_lb = in[11]; p.hg_norm = in[12]; p.mla_q_norm = in[13]; p.mla_kv_norm = in[14]; p.mla_w_uq = in[15]; p.mla_w_ukv = in[16]; p.mla_qk_q = in[17]; p.mla_qk_k = in[18];
  p.c_w_in = in[19]; p.da_lambda = in[20]; p.da_qk_q = in[21]; p.da_qk_k = in[22]; p.da_subln = in[23]; p.rt_decay = in[24]; p.rt_norm = in[25];
  p.out = (float*)d_out; p.ws = (char*)d_ws;
  hipMemsetAsync((char*)d_ws + OFF_BAR, 0, 16384, stream);
  void* args[] = {&p};
  hipError_t e = hipLaunchCooperativeKernel((void*)fwd_megakernel, dim3(grid_blocks), dim3(512), args, kDynLds, stream);
  if (e != hipSuccess) fprintf(stderr, "cooperative launch failed: %s (grid %d)\n", hipGetErrorString(e), grid_blocks);
}
```

```cpp
#include <hip/hip_runtime.h>
#include <hip/hip_cooperative_groups.h>
#include <cstdio>
#include <cstdint>
#include <cstring>
namespace cg = cooperative_groups;

#ifndef REP_ATT
#define REP_ATT 1
#endif
#ifndef REP_REC
#define REP_REC 1
#endif
#ifndef REP_GEMM
#define REP_GEMM 1
#endif
#ifndef REP_MISC
#define REP_MISC 1
#endif
#ifndef MK_CG_SYNC
#define MK_CG_SYNC 0
#endif

typedef unsigned short bf16_t;
typedef short bf16x8 __attribute__((ext_vector_type(8)));
typedef short s16x4 __attribute__((ext_vector_type(4)));
typedef float f32x2 __attribute__((ext_vector_type(2)));
typedef float f32x4 __attribute__((ext_vector_type(4)));
typedef float f32x16 __attribute__((ext_vector_type(16)));
typedef unsigned u32x2 __attribute__((ext_vector_type(2)));
typedef unsigned u32x4 __attribute__((ext_vector_type(4)));
#define LAS __attribute__((address_space(3)))

constexpr int T_TOK = 16640, NCTX = 256, DM = 1024;
constexpr float EPSN = 1e-6f;
constexpr int LSC = 260, NSC = 64;

constexpr size_t OFF_X = 0;
constexpr size_t SZ_X = (size_t)T_TOK * DM * 4;
constexpr size_t OFF_HB = OFF_X + SZ_X;
constexpr size_t SZ_HB = (size_t)T_TOK * DM * 2;
constexpr size_t OFF_Y = OFF_HB + SZ_HB;
constexpr size_t OFF_W = OFF_Y + SZ_HB;
constexpr size_t W_IN = 0, W_O = 6815744, W_1 = 8912896, W_2 = 17301504, W_UQ = 25690112, W_UKV = 26279936, SZ_W = 26804224;
constexpr size_t OFF_MOD = OFF_W + SZ_W;
constexpr size_t OFF_ROPE = OFF_MOD + 196608;
constexpr size_t OFF_LB = OFF_ROPE + 32768;
constexpr size_t OFF_SCAL = OFF_LB + 8192;
constexpr size_t OFF_BAR = OFF_SCAL + 256;
constexpr size_t OFF_PART = OFF_BAR + 16384;
constexpr size_t OFF_D = OFF_PART + 8388608;
constexpr size_t DE_QH = 0, DE_F = 34078720, DE_VH = 102236160, DE_G = 119275520, DE_CQ = 136314880, DE_S = 161873920, DE_DL = 195428352;
constexpr size_t DE_U = 0, DE_QA = 59637760, DE_KA = 85196800, DE_VA = 110755840;
constexpr size_t DO_DQK = 0, DO_DV = 34078720, DO_RQ = 51118080, DO_RK = 68157440, DO_RV = 85196800, DO_RG = 102236160, DO_OD = 119275520, DO_S = 153354240;
constexpr size_t SZ_D = 195690496;
constexpr size_t WS_NEED = OFF_D + SZ_D;

struct Params {
  const float *x, *c, *ctx, *c_ctx, *ada_w, *ada_b, *norm_w, *w_o, *mlp_w1, *mlp_w2;
  const float *a_w_in, *hg_lb, *hg_norm, *mla_q_norm, *mla_kv_norm, *mla_w_uq, *mla_w_ukv, *mla_qk_q, *mla_qk_k;
  const float *c_w_in, *da_lambda, *da_qk_q, *da_qk_k, *da_subln, *rt_decay, *rt_norm;
  float* out;
  char* ws;
};

__device__ __forceinline__ unsigned cvt_pk_bf16(float lo, float hi) { unsigned r; asm volatile("v_cvt_pk_bf16_f32 %0, %1, %2" : "=v"(r) : "v"(lo), "v"(hi)); return r; }
__device__ __forceinline__ int tid_() { int t = threadIdx.x; asm volatile("" : "+v"(t)); return t; }
typedef __bf16 bf16x2v_t __attribute__((ext_vector_type(2)));
__device__ __forceinline__ unsigned cvtb(float lo, float hi) { const f32x2 v = {lo, hi}; const bf16x2v_t r = __builtin_convertvector(v, bf16x2v_t); return __builtin_bit_cast(unsigned, r); }
__device__ __forceinline__ float bf2f(bf16_t b) { return __uint_as_float(((unsigned)b) << 16); }
__device__ __forceinline__ bf16_t f2bf(float f) { return (bf16_t)(cvt_pk_bf16(f, 0.f) & 0xffffu); }
__device__ __forceinline__ float sigmoidf_(float v) { return __builtin_amdgcn_rcpf(1.0f + __expf(-v)); }
__device__ __forceinline__ float siluf_(float v) { return v * sigmoidf_(v); }
__device__ __forceinline__ float wave_sum(float v) {
  int x = __float_as_int(v);
  v += __int_as_float(__builtin_amdgcn_update_dpp(0, x, 0xB1, 0xf, 0xf, true)); x = __float_as_int(v);
  v += __int_as_float(__builtin_amdgcn_update_dpp(0, x, 0x4E, 0xf, 0xf, true)); x = __float_as_int(v);
  v += __int_as_float(__builtin_amdgcn_update_dpp(0, x, 0x124, 0xf, 0xf, true)); x = __float_as_int(v);
  v += __int_as_float(__builtin_amdgcn_update_dpp(0, x, 0x128, 0xf, 0xf, true));
  { auto r = __builtin_amdgcn_permlane16_swap(__float_as_uint(v), __float_as_uint(v), false, false); v = __uint_as_float(r[0]) + __uint_as_float(r[1]); }
  { auto r = __builtin_amdgcn_permlane32_swap(__float_as_uint(v), __float_as_uint(v), false, false); v = __uint_as_float(r[0]) + __uint_as_float(r[1]); }
  return v;
}
__device__ __forceinline__ void store_bf16x4(bf16_t* p, f32x4 v) { u32x2 w; w.x = cvt_pk_bf16(v[0], v[1]); w.y = cvt_pk_bf16(v[2], v[3]); *(u32x2*)p = w; }

namespace pg8 {
constexpr int BM = 256, BK = 64, HALF = 128, HTB = HALF * BK * 2, STAGE_BYTES = 8 * HTB, NXCD = 8, WGM = 8;
__device__ __forceinline__ int lds_byte(int r, int c) { const int st = (r >> 4) * 2 + (c >> 5), rr = r & 15, cc = c & 31, ob = rr * 64 + cc * 2; return st * 1024 + (ob ^ (((ob >> 9) & 1) << 5)); }
__device__ __forceinline__ void stage_rc(int b, int& R, int& C) { const int st = b / 1024, sb = b % 1024, swz = sb ^ (((sb >> 9) & 1) << 5); R = (st >> 1) * 16 + swz / 64; C = (st & 1) * 32 + (swz % 64) / 2; }
struct Unit { int pm, pn, ko; };
struct Gemm { const bf16_t* A; const bf16_t* Bt; int M, N, K, lda, ldb; };
struct StaticOrder {
  int nM, nN, nwg, G, c, pm0;
  __device__ void init(int M, int N, int G_, int c_, int pm0_) { pm0 = pm0_; nM = M / BM - pm0_; nN = N / BM; nwg = nM * nN; G = G_; c = c_; }
  __device__ bool next(int i, Unit& u) const {
    const long L = (long)i * G + c; if (L >= nwg) return false;
    int wgid = (int)L; { const int q = nwg / NXCD, r = nwg % NXCD, xcd = wgid % NXCD, off = wgid / NXCD; wgid = (xcd < r ? xcd * (q + 1) : r * (q + 1) + (xcd - r) * q) + off; }
    const int nig = WGM * nN, gid = wgid / nig, fm = gid * WGM, gsz = (nM - fm) < WGM ? (nM - fm) : WGM;
    u.pm = fm + ((wgid % nig) % gsz) + pm0; u.pn = (wgid % nig) / gsz; u.ko = 0; return true;
  }
};

struct SplitKOrder {
  int nN, nwg, G, c, ks;
  __device__ void init(int N, int nslices, int ks_, int G_, int c_) { nN = N / BM; nwg = nN * nslices; G = G_; c = c_; ks = ks_; }
  __device__ bool next(int i, Unit& u) const { const long L = (long)i * G + c; if (L >= nwg) return false; u.pm = 0; u.pn = (int)L % nN; u.ko = ((int)L / nN) * ks; return true; }
};
template <class Epi, class Sched>
__device__ __forceinline__ void gemm_phase(LAS unsigned char* lds, const Gemm g, const Sched& S, const Epi& E) {
  const int tid = tid_(), wid = __builtin_amdgcn_readfirstlane(tid >> 6), lane = tid & 63, wr = wid >> 2, wc = wid & 3, fr = lane & 15, fq = lane >> 4;
  const int K = g.K, nt = K / BK;
  unsigned voffA[2], voffB[2];
#pragma unroll
  for (int i = 0; i < 2; ++i) { int R, C; stage_rc(tid * 16 + i * 8192, R, C);
    voffA[i] = (unsigned)(R * g.lda + C) * 2u; voffB[i] = (unsigned)(R * g.ldb + C) * 2u; }
  const size_t kstep = (size_t)(BK * 2);
  const size_t hstepA = (size_t)HALF * g.lda * 2, hstepB = (size_t)HALF * g.ldb * 2;
  const size_t tstepA = 2 * hstepA, tstepB = 2 * hstepB;
  const unsigned ldsw = (unsigned)wid * 1024u;
  const int aoff = lds_byte(wr * 64 + fr, fq * 8), boff = lds_byte(wc * 32 + fr, fq * 8);
#define PG8_SA(b, h) (((b) * 2 + (h)) * HTB)
#define PG8_SB(b, h) ((4 + (b) * 2 + (h)) * HTB)
#define PG8_STAGE(bufoff, gbase, voff) do { _Pragma("unroll") for (int _i = 0; _i < 2; ++_i) \
    __builtin_amdgcn_global_load_lds((const unsigned*)((const char*)(gbase) + (voff)[_i]), (LAS unsigned*)(lds + (bufoff) + ldsw + _i * 8192), 16, 0, 0); } while (0)
#define PG8_LDA(dst, b, h) do { _Pragma("unroll") for (int m = 0; m < 4; ++m) _Pragma("unroll") for (int k = 0; k < 2; ++k) dst[m][k] = *(const LAS bf16x8*)(lds + PG8_SA(b, h) + aoff + m * 2048 + k * 1024); } while (0)
#define PG8_LDB(dst, b, h) do { _Pragma("unroll") for (int n = 0; n < 2; ++n) _Pragma("unroll") for (int k = 0; k < 2; ++k) dst[n][k] = *(const LAS bf16x8*)(lds + PG8_SB(b, h) + boff + n * 2048 + k * 1024); } while (0)
#define PG8_MMA(ai, bj, At, Bt) do { __builtin_amdgcn_s_setprio(1); _Pragma("unroll") for (int m = 0; m < 4; ++m) _Pragma("unroll") for (int n = 0; n < 2; ++n) _Pragma("unroll") for (int k = 0; k < 2; ++k) \
    acc[ai][bj][m][n] = __builtin_amdgcn_mfma_f32_16x16x32_bf16(Bt[n][k], At[m][k], acc[ai][bj][m][n], 0, 0, 0); __builtin_amdgcn_s_setprio(0); } while (0)
#define PG8_WAIT_V(n) asm volatile("s_waitcnt vmcnt(" #n ")" ::: "memory")
#define PG8_WAIT_L(n) asm volatile("s_waitcnt lgkmcnt(" #n ")" ::: "memory")
#define PG8_BAR __builtin_amdgcn_s_barrier()
#define PG8_SCHED __builtin_amdgcn_sched_barrier(0)
  Unit cur, nxt; int ui = 0;
  if (!S.next(0, cur)) return;
  f32x4 acc[2][2][4][2];
#pragma unroll
  for (int a = 0; a < 2; ++a)
#pragma unroll
    for (int b = 0; b < 2; ++b)
#pragma unroll
      for (int m = 0; m < 4; ++m)
#pragma unroll
        for (int n = 0; n < 2; ++n) acc[a][b][m][n] = (f32x4){0.f, 0.f, 0.f, 0.f};
  bf16x8 At[4][2], B0[2][2], B1[2][2];
  const char* cA = (const char*)g.A + (size_t)cur.pm * tstepA + (size_t)cur.ko * 2; const char* cB = (const char*)g.Bt + (size_t)cur.pn * tstepB + (size_t)cur.ko * 2;
  PG8_STAGE(PG8_SB(0, 0), cB, voffB); PG8_STAGE(PG8_SA(0, 0), cA, voffA); PG8_STAGE(PG8_SB(0, 1), cB + hstepB, voffB); PG8_STAGE(PG8_SA(0, 1), cA + hstepA, voffA);
  if (wr == 1) PG8_BAR;
  PG8_WAIT_V(4); PG8_BAR;
  PG8_STAGE(PG8_SB(1, 0), cB + kstep, voffB); PG8_STAGE(PG8_SA(1, 0), cA + kstep, voffA); PG8_STAGE(PG8_SB(1, 1), cB + hstepB + kstep, voffB);
  PG8_WAIT_V(6); PG8_BAR;
  for (;;) {
    const bool has_next = S.next(ui + 1, nxt);
    const char* nA = has_next ? (const char*)g.A + (size_t)nxt.pm * tstepA + (size_t)nxt.ko * 2 : cA; const char* nB = has_next ? (const char*)g.Bt + (size_t)nxt.pn * tstepB + (size_t)nxt.ko * 2 : cB;
    for (int t = 0; t < nt; t += 2) {
      const bool last = (t == nt - 2);
      const char* a1 = cA + (size_t)(t + 1) * kstep;
      const char* a2 = last ? nA : cA + (size_t)(t + 2) * kstep; const char* b2 = last ? nB : cB + (size_t)(t + 2) * kstep;
      const char* a3 = a2 + kstep; const char* b3 = b2 + kstep;
      PG8_LDB(B0, 0, 0); PG8_SCHED; PG8_LDA(At, 0, 0); PG8_STAGE(PG8_SA(1, 1), a1 + hstepA, voffA);
      PG8_WAIT_L(8); PG8_BAR; PG8_WAIT_L(0); PG8_MMA(0, 0, At, B0); PG8_BAR; PG8_SCHED;
      PG8_LDB(B1, 0, 1); PG8_STAGE(PG8_SB(0, 0), b2, voffB);
      PG8_BAR; PG8_WAIT_L(0); PG8_MMA(0, 1, At, B1); PG8_BAR;
      PG8_LDA(At, 0, 1); PG8_STAGE(PG8_SA(0, 0), a2, voffA);
      PG8_BAR; PG8_WAIT_L(0); PG8_MMA(1, 0, At, B0); PG8_BAR; PG8_SCHED;
      PG8_STAGE(PG8_SB(0, 1), b2 + hstepB, voffB);
      PG8_WAIT_V(6); PG8_BAR; PG8_MMA(1, 1, At, B1); PG8_BAR;
      PG8_LDB(B0, 1, 0); PG8_SCHED; PG8_LDA(At, 1, 0); PG8_STAGE(PG8_SA(0, 1), a2 + hstepA, voffA);
      PG8_WAIT_L(8); PG8_BAR; PG8_WAIT_L(0); PG8_MMA(0, 0, At, B0); PG8_BAR; PG8_SCHED;
      PG8_LDB(B1, 1, 1); PG8_STAGE(PG8_SB(1, 0), b3, voffB);
      PG8_BAR; PG8_WAIT_L(0); PG8_MMA(0, 1, At, B1); PG8_BAR;
      PG8_LDA(At, 1, 1); PG8_STAGE(PG8_SA(1, 0), a3, voffA);
      PG8_BAR; PG8_WAIT_L(0); PG8_MMA(1, 0, At, B0); PG8_BAR; PG8_SCHED;
      PG8_STAGE(PG8_SB(1, 1), b3 + hstepB, voffB);
      PG8_WAIT_V(6); PG8_BAR; PG8_MMA(1, 1, At, B1); PG8_BAR;
    }
    E(acc, cur, wr, wc, fr, fq);
    if (!has_next) break;
#pragma unroll
    for (int a = 0; a < 2; ++a)
#pragma unroll
      for (int b = 0; b < 2; ++b)
#pragma unroll
        for (int m = 0; m < 4; ++m)
#pragma unroll
          for (int n = 0; n < 2; ++n) acc[a][b][m][n] = (f32x4){0.f, 0.f, 0.f, 0.f};
    cur = nxt; cA = nA; cB = nB; ++ui;
  }
  PG8_WAIT_V(0);
  if (wr == 0) PG8_BAR;
  PG8_BAR;
#undef PG8_SA
#undef PG8_SB
#undef PG8_STAGE
#undef PG8_LDA
#undef PG8_LDB
#undef PG8_MMA
#undef PG8_WAIT_V
#undef PG8_WAIT_L
#undef PG8_BAR
#undef PG8_SCHED
}
}

#define EPI_LOOP(BODY) \
  const int row0 = u.pm * 256 + wr * 64 + fr, colt = u.pn * 256 + wc * 32 + 4 * fq; \
  _Pragma("unroll") for (int ai = 0; ai < 2; ++ai) _Pragma("unroll") for (int m = 0; m < 4; ++m) { const int row = row0 + ai * 128 + m * 16; (void)row; \
    _Pragma("unroll") for (int bj = 0; bj < 2; ++bj) _Pragma("unroll") for (int n = 0; n < 2; ++n) { const int col = colt + bj * 128 + n * 16; f32x4 v = acc[ai][bj][m][n]; BODY } }

struct EpiG1Even {
  bf16_t* QH; float* F; bf16_t* VH; bf16_t* G; bf16_t* CQ; const float* LBj;
  __device__ __forceinline__ void operator()(const f32x4 (&acc)[2][2][4][2], const pg8::Unit& u, int wr, int wc, int fr, int fq) const {
    const int pn = u.pn;
    EPI_LOOP(
      if (pn < 2) { f32x4 o; for (int j = 0; j < 4; ++j) o[j] = siluf_(v[j]); store_bf16x4(QH + (size_t)row * 512 + col, o); }
      else if (pn < 6) { const int c = col - 512; const f32x4 lb = *(const f32x4*)(LBj + c); f32x4 o; for (int j = 0; j < 4; ++j) o[j] = lb[j] + (1.f - lb[j]) * sigmoidf_(v[j]); *(f32x4*)(F + (size_t)row * 1024 + c) = o; }
      else if (pn < 8) { store_bf16x4(VH + (size_t)row * 512 + (col - 1536), v); }
      else if (pn < 10) { f32x4 o; for (int j = 0; j < 4; ++j) o[j] = siluf_(v[j]); store_bf16x4(G + (size_t)row * 512 + (col - 2048), o); }
      else { store_bf16x4(CQ + (size_t)row * 768 + (col - 2560), v); }
    )
  }
};
struct EpiG1Odd {
  bf16_t* DQK; bf16_t* DV; float* RQ; float* RK; bf16_t* RV; bf16_t* RG; const float* ROPE;
  __device__ __forceinline__ void operator()(const f32x4 (&acc)[2][2][4][2], const pg8::Unit& u, int wr, int wc, int fr, int fq) const {
    const int pn = u.pn;
    if (pn == 6 || pn == 7) {
      float* dst = pn == 6 ? RQ : RK; const float sc = pn == 6 ? 1.f : 0.125f; const int ax = wc & 1;
      const int row0 = u.pm * 256 + wr * 64 + fr, colt = wc * 32 + 4 * fq;
#pragma unroll
      for (int ai = 0; ai < 2; ++ai)
#pragma unroll
        for (int m = 0; m < 4; ++m) { const int row = row0 + ai * 128 + m * 16;
          f32x4 cs = {1.f, 1.f, 1.f, 1.f}, sn = {0.f, 0.f, 0.f, 0.f};
          if (row >= NCTX) { const int t = row - NCTX; const int pos = ax ? (t & 63) : (t >> 6); const float* rp = ROPE + pos * 32 + (4 * fq) * 2;
            const f32x4 a = *(const f32x4*)rp, b = *(const f32x4*)(rp + 4); cs = (f32x4){a[0], a[2], b[0], b[2]}; sn = (f32x4){a[1], a[3], b[1], b[3]}; }
#pragma unroll
          for (int bj = 0; bj < 2; ++bj) { const f32x4 x0 = acc[ai][bj][m][0] * sc, x1 = acc[ai][bj][m][1] * sc;
            const f32x4 o0 = x0 * cs - x1 * sn, o1 = x1 * cs + x0 * sn; const int col = colt + bj * 128;
            *(f32x4*)(dst + (size_t)row * 256 + col) = o0; *(f32x4*)(dst + (size_t)row * 256 + col + 16) = o1; } }
      return;
    }
    EPI_LOOP(
      if (pn < 4) { store_bf16x4(DQK + (size_t)row * 1024 + col, v); }
      else if (pn < 6) { store_bf16x4(DV + (size_t)row * 512 + (col - 1024), v); }
      else if (pn < 10) { store_bf16x4(RV + (size_t)row * 512 + (col - 2048), v); }
      else { f32x4 o; for (int j = 0; j < 4; ++j) o[j] = siluf_(v[j]); store_bf16x4(RG + (size_t)row * 512 + (col - 2560), o); }
    )
  }
};
struct EpiBf16Off { bf16_t* O; int ldo, coff;
  __device__ __forceinline__ void operator()(const f32x4 (&acc)[2][2][4][2], const pg8::Unit& u, int wr, int wc, int fr, int fq) const {
    EPI_LOOP( store_bf16x4(O + (size_t)row * ldo + coff + col, v); ) } };
struct EpiSqRelu { bf16_t* O; int ldo;
  __device__ __forceinline__ void operator()(const f32x4 (&acc)[2][2][4][2], const pg8::Unit& u, int wr, int wc, int fr, int fq) const {
    EPI_LOOP( f32x4 o; for (int j = 0; j < 4; ++j) { const float r = fmaxf(v[j], 0.f); o[j] = r * r; } store_bf16x4(O + (size_t)row * ldo + col, o); ) } };
struct EpiResid {
  float* X; const float* gL; const float* gC; float* out; const float* Xin;
  __device__ __forceinline__ void operator()(const f32x4 (&acc)[2][2][4][2], const pg8::Unit& u, int wr, int wc, int fr, int fq) const {
    EPI_LOOP( const float* gp = row < NCTX ? gC : gL; const f32x4 gt = *(const f32x4*)(gp + col); float* xp = X + (size_t)row * DM + col;
      const float* rp = Xin ? Xin + (size_t)(row - NCTX) * DM + col : xp; const f32x4 r = *(const f32x4*)rp + gt * v;
      if (out) { if (row >= NCTX) *(f32x4*)(out + (size_t)(row - NCTX) * DM + col) = r; } else *(f32x4*)xp = r; ) } };

struct EpiPartial {
  float* PB; const float* gC; int ks;
  __device__ __forceinline__ void operator()(const f32x4 (&acc)[2][2][4][2], const pg8::Unit& u, int wr, int wc, int fr, int fq) const {
    float* pb = PB + (size_t)(u.ko / ks) * NCTX * DM;
    EPI_LOOP( const f32x4 gt = *(const f32x4*)(gC + col); *(f32x4*)(pb + (size_t)row * DM + col) = gt * v; ) } };

__device__ __forceinline__ int crow(int r, int hi) { return (r & 3) + 8 * (r >> 2) + 4 * hi; }
#define SBAR() __builtin_amdgcn_sched_barrier(0)
__device__ __forceinline__ void partialSM(f32x16& p0, f32x16& p1, float& m_reg, float& mn, float& alpha, const float C, const float thr) {
  float pmax = p0[0];
#pragma unroll
  for (int r = 1; r < 16; ++r) pmax = fmaxf(pmax, p0[r]);
#pragma unroll
  for (int r = 0; r < 16; ++r) pmax = fmaxf(pmax, p1[r]);
  { auto rr = __builtin_amdgcn_permlane32_swap(__float_as_uint(pmax), __float_as_uint(pmax), false, false);
    pmax = fmaxf(__uint_as_float(rr[0]), __uint_as_float(rr[1])); }
  if (__builtin_expect(__all(pmax - m_reg <= thr), 1)) { mn = m_reg; alpha = 1.f; }
  else { mn = fmaxf(m_reg, pmax); alpha = __builtin_amdgcn_exp2f((m_reg - mn) * C); m_reg = mn; }
  const float mnC = -mn * C;
#pragma unroll
  for (int r = 0; r < 16; ++r) p0[r] = fmaf(p0[r], C, mnC);
#pragma unroll
  for (int r = 0; r < 16; ++r) p1[r] = fmaf(p1[r], C, mnC);
#pragma unroll
  for (int r = 0; r < 16; ++r) p0[r] = __builtin_amdgcn_exp2f(p0[r]);
}
__device__ __forceinline__ void decideSM(const f32x16& p0, const f32x16& p1, float& m_reg, float& mn, float& alpha, const float C, const float thr) {
  float pmax = p0[0];
#pragma unroll
  for (int r = 1; r < 16; ++r) pmax = fmaxf(pmax, p0[r]);
#pragma unroll
  for (int r = 0; r < 16; ++r) pmax = fmaxf(pmax, p1[r]);
  { auto rr = __builtin_amdgcn_permlane32_swap(__float_as_uint(pmax), __float_as_uint(pmax), false, false);
    pmax = fmaxf(__uint_as_float(rr[0]), __uint_as_float(rr[1])); }
  if (__builtin_expect(__all(pmax - m_reg <= thr), 1)) { mn = m_reg; alpha = 1.f; }
  else { mn = fmaxf(m_reg, pmax); alpha = __builtin_amdgcn_exp2f((m_reg - mn) * C); m_reg = mn; }
}
__device__ __forceinline__ void finishSM(f32x16& p0, f32x16& p1, float alpha, float& l_reg, bf16x8& pa0, bf16x8& pa1, bf16x8& pa2, bf16x8& pa3) {
#pragma unroll
  for (int r = 0; r < 16; ++r) p1[r] = __builtin_amdgcn_exp2f(p1[r]);
  float ps = 0;
#pragma unroll
  for (int r = 0; r < 16; ++r) ps += p0[r];
#pragma unroll
  for (int r = 0; r < 16; ++r) ps += p1[r];
  { auto rr = __builtin_amdgcn_permlane32_swap(__float_as_uint(ps), __float_as_uint(ps), false, false);
    ps = __uint_as_float(rr[0]) + __uint_as_float(rr[1]); }
  l_reg = l_reg * alpha + ps;
#define PK4(P, BASE, OUT) do { u32x4 w = {cvtb(P[BASE + 0], P[BASE + 1]), cvtb(P[BASE + 2], P[BASE + 3]), \
    cvtb(P[BASE + 4], P[BASE + 5]), cvtb(P[BASE + 6], P[BASE + 7])}; OUT = *reinterpret_cast<bf16x8*>(&w); } while (0)
  PK4(p0, 0, pa0); PK4(p0, 8, pa1); PK4(p1, 0, pa2); PK4(p1, 8, pa3);
#undef PK4
}
template <int NQK>
__device__ __forceinline__ void qkt(f32x16& p0, f32x16& p1, const char* Ks, const bf16x8* qr, int r32, int hi) {
  constexpr int KROW = NQK * 32 + 16;
  p0 = f32x16{}; p1 = f32x16{};
#pragma unroll
  for (int d0 = 0; d0 < NQK; ++d0) { const int cb = (d0 * 16 + hi * 8) * 2;
    bf16x8 b0 = *reinterpret_cast<const bf16x8*>(Ks + r32 * KROW + cb);
    bf16x8 b1 = *reinterpret_cast<const bf16x8*>(Ks + (32 + r32) * KROW + cb);
    p0 = __builtin_amdgcn_mfma_f32_32x32x16_bf16(b0, qr[d0], p0, 0, 0, 0);
    p1 = __builtin_amdgcn_mfma_f32_32x32x16_bf16(b1, qr[d0], p1, 0, 0, 0); }
}
template <int NQK>
__device__ __forceinline__ void qkt_mi(f32x16& p0, f32x16& p1, const char* Ks, const bf16x8* qr, int r32, int hi, const f32x16& minit) {
  constexpr int KROW = NQK * 32 + 16;
#pragma unroll
  for (int d0 = 0; d0 < NQK; ++d0) { const int cb = (d0 * 16 + hi * 8) * 2;
    bf16x8 b0 = *reinterpret_cast<const bf16x8*>(Ks + r32 * KROW + cb);
    bf16x8 b1 = *reinterpret_cast<const bf16x8*>(Ks + (32 + r32) * KROW + cb);
    if (d0 == 0) { p0 = __builtin_amdgcn_mfma_f32_32x32x16_bf16(b0, qr[0], minit, 0, 0, 0); p1 = __builtin_amdgcn_mfma_f32_32x32x16_bf16(b1, qr[0], minit, 0, 0, 0); }
    else { p0 = __builtin_amdgcn_mfma_f32_32x32x16_bf16(b0, qr[d0], p0, 0, 0, 0); p1 = __builtin_amdgcn_mfma_f32_32x32x16_bf16(b1, qr[d0], p1, 0, 0, 0); } }
}
__device__ __forceinline__ void decide_mi(f32x16& p0, f32x16& p1, f32x16& minit, float& M, float& alpha, const float thr2, const bool first) {
  float pmax = p0[0];
#pragma unroll
  for (int r = 1; r < 16; ++r) pmax = fmaxf(pmax, p0[r]);
#pragma unroll
  for (int r = 0; r < 16; ++r) pmax = fmaxf(pmax, p1[r]);
  { auto rr = __builtin_amdgcn_permlane32_swap(__float_as_uint(pmax), __float_as_uint(pmax), false, false);
    pmax = fmaxf(__uint_as_float(rr[0]), __uint_as_float(rr[1])); }
  if (__builtin_expect(!first && __all(pmax <= thr2), 1)) { alpha = 1.f; }
  else { const float delta = first ? pmax : fmaxf(pmax, 0.f); alpha = first ? 1.f : __builtin_amdgcn_exp2f(-delta); M += delta;
#pragma unroll
    for (int r = 0; r < 16; ++r) { p0[r] -= delta; p1[r] -= delta; minit[r] = -M; } }
}
__device__ __forceinline__ int v_st(int k, int c) { const int kk = k; return ((kk >> 3) * 4 + (c >> 5)) * 512 + ((kk & 7) * 32 + (c & 31)) * 2; }
__device__ __forceinline__ int v_rd_base(int lane) { return ((lane & 3) << 3) | (((lane >> 2) & 3) << 6) | (((lane >> 4) & 1) << 5) | (((lane >> 5) & 1) << 8); }
constexpr int v_rd_off(int d0, int ks, int half) { return d0 * 512 + ks * 4096 + half * 2048; }
template <int OFF> __device__ __forceinline__ s16x4 tr_read(int vb) {
  s16x4 r; asm volatile("ds_read_b64_tr_b16 %0, %1 offset:%2" : "=&v"(r) : "v"(vb), "i"(OFF) : "memory"); return r;
}
template <int D0> __device__ __forceinline__ void pv_one(f32x16& od, int vb, bf16x8 pa0, bf16x8 pa1, bf16x8 pa2, bf16x8 pa3) {
  const s16x4 l0 = tr_read<v_rd_off(D0, 0, 0)>(vb), h0 = tr_read<v_rd_off(D0, 0, 1)>(vb), l1 = tr_read<v_rd_off(D0, 1, 0)>(vb), h1 = tr_read<v_rd_off(D0, 1, 1)>(vb);
  const s16x4 l2 = tr_read<v_rd_off(D0, 2, 0)>(vb), h2 = tr_read<v_rd_off(D0, 2, 1)>(vb), l3 = tr_read<v_rd_off(D0, 3, 0)>(vb), h3 = tr_read<v_rd_off(D0, 3, 1)>(vb);
  asm volatile("s_waitcnt lgkmcnt(0)" ::: "memory"); SBAR();
#define PK(L, H) (bf16x8){L[0], L[1], L[2], L[3], H[0], H[1], H[2], H[3]}
  od = __builtin_amdgcn_mfma_f32_32x32x16_bf16(pa0, PK(l0, h0), od, 0, 0, 0);
  od = __builtin_amdgcn_mfma_f32_32x32x16_bf16(pa1, PK(l1, h1), od, 0, 0, 0);
  od = __builtin_amdgcn_mfma_f32_32x32x16_bf16(pa2, PK(l2, h2), od, 0, 0, 0);
  od = __builtin_amdgcn_mfma_f32_32x32x16_bf16(pa3, PK(l3, h3), od, 0, 0, 0);
#undef PK
}
template <int D0> __device__ __forceinline__ void pv_one_sm(f32x16& od, int vb, bf16x8 pa0, bf16x8 pa1, bf16x8 pa2, bf16x8 pa3, f32x16& q0, f32x16& q1, const float C, const float mnC) {
  const s16x4 l0 = tr_read<v_rd_off(D0, 0, 0)>(vb), h0 = tr_read<v_rd_off(D0, 0, 1)>(vb), l1 = tr_read<v_rd_off(D0, 1, 0)>(vb), h1 = tr_read<v_rd_off(D0, 1, 1)>(vb);
  const s16x4 l2 = tr_read<v_rd_off(D0, 2, 0)>(vb), h2 = tr_read<v_rd_off(D0, 2, 1)>(vb), l3 = tr_read<v_rd_off(D0, 3, 0)>(vb), h3 = tr_read<v_rd_off(D0, 3, 1)>(vb);
  asm volatile("s_waitcnt lgkmcnt(0)" ::: "memory"); SBAR();
#define PK(L, H) (bf16x8){L[0], L[1], L[2], L[3], H[0], H[1], H[2], H[3]}
  od = __builtin_amdgcn_mfma_f32_32x32x16_bf16(pa0, PK(l0, h0), od, 0, 0, 0);
  od = __builtin_amdgcn_mfma_f32_32x32x16_bf16(pa1, PK(l1, h1), od, 0, 0, 0);
  od = __builtin_amdgcn_mfma_f32_32x32x16_bf16(pa2, PK(l2, h2), od, 0, 0, 0);
  od = __builtin_amdgcn_mfma_f32_32x32x16_bf16(pa3, PK(l3, h3), od, 0, 0, 0);
#undef PK
  if (D0 < 2) {
#pragma unroll
    for (int r = 8 * D0; r < 8 * D0 + 8; ++r) q0[r] = __builtin_amdgcn_exp2f(fmaf(q0[r], C, mnC));
  } else {
#pragma unroll
    for (int r = 8 * (D0 - 2); r < 8 * (D0 - 2) + 8; ++r) q1[r] = fmaf(q1[r], C, mnC);
  }
}
__device__ __forceinline__ void pv_sm(f32x16* o, int vb, bf16x8 pa0, bf16x8 pa1, bf16x8 pa2, bf16x8 pa3, f32x16& q0, f32x16& q1, const float C, const float mn) {
  const float mnC = -mn * C;
  pv_one_sm<0>(o[0], vb, pa0, pa1, pa2, pa3, q0, q1, C, mnC); pv_one_sm<1>(o[1], vb, pa0, pa1, pa2, pa3, q0, q1, C, mnC);
  pv_one_sm<2>(o[2], vb, pa0, pa1, pa2, pa3, q0, q1, C, mnC); pv_one_sm<3>(o[3], vb, pa0, pa1, pa2, pa3, q0, q1, C, mnC);
}
__device__ __forceinline__ void pv_d0(f32x16* o, int vb, bf16x8 pa0, bf16x8 pa1, bf16x8 pa2, bf16x8 pa3) {
  pv_one<0>(o[0], vb, pa0, pa1, pa2, pa3); pv_one<1>(o[1], vb, pa0, pa1, pa2, pa3); pv_one<2>(o[2], vb, pa0, pa1, pa2, pa3); pv_one<3>(o[3], vb, pa0, pa1, pa2, pa3);
}

template <int D0> __device__ __forceinline__ void pv_one_mi(f32x16& od, int vb, bf16x8 pa0, bf16x8 pa1, bf16x8 pa2, bf16x8 pa3, f32x16& q0) {
  const s16x4 l0 = tr_read<v_rd_off(D0, 0, 0)>(vb), h0 = tr_read<v_rd_off(D0, 0, 1)>(vb), l1 = tr_read<v_rd_off(D0, 1, 0)>(vb), h1 = tr_read<v_rd_off(D0, 1, 1)>(vb);
  const s16x4 l2 = tr_read<v_rd_off(D0, 2, 0)>(vb), h2 = tr_read<v_rd_off(D0, 2, 1)>(vb), l3 = tr_read<v_rd_off(D0, 3, 0)>(vb), h3 = tr_read<v_rd_off(D0, 3, 1)>(vb);
  asm volatile("s_waitcnt lgkmcnt(0)" ::: "memory"); SBAR();
#define PK(L, H) (bf16x8){L[0], L[1], L[2], L[3], H[0], H[1], H[2], H[3]}
  od = __builtin_amdgcn_mfma_f32_32x32x16_bf16(pa0, PK(l0, h0), od, 0, 0, 0);
  od = __builtin_amdgcn_mfma_f32_32x32x16_bf16(pa1, PK(l1, h1), od, 0, 0, 0);
  od = __builtin_amdgcn_mfma_f32_32x32x16_bf16(pa2, PK(l2, h2), od, 0, 0, 0);
  od = __builtin_amdgcn_mfma_f32_32x32x16_bf16(pa3, PK(l3, h3), od, 0, 0, 0);
#undef PK
#pragma unroll
  for (int r = 4 * D0; r < 4 * D0 + 4; ++r) q0[r] = __builtin_amdgcn_exp2f(q0[r]);
}
__device__ __forceinline__ void pv_mi(f32x16* o, int vb, bf16x8 pa0, bf16x8 pa1, bf16x8 pa2, bf16x8 pa3, f32x16& q0) {
  pv_one_mi<0>(o[0], vb, pa0, pa1, pa2, pa3, q0); pv_one_mi<1>(o[1], vb, pa0, pa1, pa2, pa3, q0);
  pv_one_mi<2>(o[2], vb, pa0, pa1, pa2, pa3, q0); pv_one_mi<3>(o[3], vb, pa0, pa1, pa2, pa3, q0);
}
template <int NQK, int SD, bool MI>
__device__ __forceinline__ void attn_body(const bf16_t* __restrict__ Qb, int ldq, const bf16_t* __restrict__ Kh, int ldk, const bf16_t* __restrict__ Vh, int ldv,
                                          bf16_t* __restrict__ Ob, int ldo, int seq, float scale, char* lds) {
  constexpr int KROW = NQK * 32 + 16, KT = 64 * KROW, NP = NQK / 4, PPR = NQK * 2, SHM_V = 16384;
  const float C = scale * 1.4426950408889634f, thr = 8.f / scale;
  const int tid = tid_(), wid = tid >> 6, lane = tid & 63, r32 = lane & 31, hi = lane >> 5;
  char* V_lds = lds; char* K_lds = lds + 3 * SHM_V;
  float* wsl = (float*)(lds + 3 * SHM_V + 3 * KT) + wid * 64; float* li_l = wsl; float* al_l = wsl + 32;
  float m_reg = -1e30f, l_reg = 0; f32x16 o[4] = {}; bf16x8 qr[NQK];
  const bf16_t* Qw = Qb + (long)(wid * 32 + r32) * ldq + hi * 8;
#pragma unroll
  for (int d0 = 0; d0 < NQK; ++d0) qr[d0] = *reinterpret_cast<const bf16x8*>(Qw + d0 * 16);
  f32x16 minit = {}; float Mref = 0.f; const float thr2 = 8.f * 1.4426950408889634f;
  if constexpr (MI) {
#pragma unroll
    for (int d0 = 0; d0 < NQK; ++d0) { u32x4 w = *reinterpret_cast<u32x4*>(&qr[d0]);
#pragma unroll
      for (int e = 0; e < 4; ++e) { const float lo = __uint_as_float(w[e] << 16) * C, hi2 = __uint_as_float(w[e] & 0xffff0000u) * C; w[e] = cvtb(lo, hi2); }
      qr[d0] = *reinterpret_cast<bf16x8*>(&w); }
  }
  constexpr bool RECOMP = false;
  const int p_voffV = ((tid >> 4) * ldv + (tid & 15) * 8) * 2, p_vstV = v_st(tid >> 4, (tid & 15) * 8);
  const int p_voffK = ((tid >> 3) * ldk + (tid & 7) * 8) * 2, p_ldsK = (tid >> 3) * KROW + (tid & 7) * 16;
#define STG_T() int _t = tid; if constexpr (RECOMP) asm volatile("" : "+v"(_t));
#define VOFFV() (RECOMP ? ((_t >> 4) * ldv + (_t & 15) * 8) * 2 : p_voffV)
#define VSTV() (RECOMP ? v_st(_t >> 4, (_t & 15) * 8) : p_vstV)
#define VOFFK() (RECOMP ? ((_t >> 3) * ldk + (_t & 7) * 8) * 2 : p_voffK)
#define LDSK() (RECOMP ? (_t >> 3) * KROW + (_t & 7) * 16 : p_ldsK)
  const auto rK = __builtin_amdgcn_make_buffer_rsrc((void*)Kh, 0, 0x7ffffff0, 0x00020000);
  const auto rV = __builtin_amdgcn_make_buffer_rsrc((void*)Vh, 0, 0x7ffffff0, 0x00020000);
  const int vb0 = (int)(uintptr_t)V_lds + v_rd_base(lane);
  struct { u32x4 vs0, vs1; u32x4 ks[NP]; } sr_[SD];
#define SLOAD(i, k0) do { STG_T() const int _sV = (k0) * ldv * 2, _sK = (k0) * ldk * 2, _vv = VOFFV(), _vk = VOFFK(); \
    sr_[i].vs0 = __builtin_amdgcn_raw_buffer_load_b128(rV, _vv, _sV, 0); sr_[i].vs1 = __builtin_amdgcn_raw_buffer_load_b128(rV, _vv, _sV + 32 * ldv * 2, 0); \
    _Pragma("unroll") for (int _p = 0; _p < NP; ++_p) sr_[i].ks[_p] = __builtin_amdgcn_raw_buffer_load_b128(rK, _vk + _p * 128, _sK, 0); } while (0)
#define SWRITE(b, i) do { STG_T() const int _sv = VSTV(), _sk = LDSK(); *(u32x4*)(V_lds + (b) * SHM_V + _sv) = sr_[i].vs0; *(u32x4*)(V_lds + (b) * SHM_V + _sv + 8192) = sr_[i].vs1; \
    _Pragma("unroll") for (int _p = 0; _p < NP; ++_p) *(u32x4*)(K_lds + (b) * KT + _sk + _p * 128) = sr_[i].ks[_p]; } while (0)
#define SWAIT() do { if constexpr (SD == 2) { if constexpr (NP == 1) asm volatile("s_waitcnt vmcnt(3)" ::: "memory"); else asm volatile("s_waitcnt vmcnt(5)" ::: "memory"); } else asm volatile("s_waitcnt vmcnt(0)" ::: "memory"); } while (0)
#define RESC(a) do { if (__any((a) < 1.f)) { if (hi == 0) al_l[r32] = (a); asm volatile("s_waitcnt lgkmcnt(0)" ::: "memory"); \
    _Pragma("unroll") for (int d = 0; d < 4; ++d) _Pragma("unroll") for (int r = 0; r < 16; ++r) o[d][r] *= al_l[crow(r, hi)]; } } while (0)
  f32x16 pA0, pA1, pB0, pB1; float mnA, mnB, alA, alB; bf16x8 pa0, pa1, pa2, pa3; const int NT = seq / 64;
  constexpr int SE = 0, SO = SD - 1;
  if (__builtin_amdgcn_readfirstlane(tid) >= 256) __builtin_amdgcn_s_setprio(1);
  __syncthreads();
#define QKT(P0, P1, KS) do { if constexpr (MI) qkt_mi<NQK>(P0, P1, KS, qr, r32, hi, minit); else qkt<NQK>(P0, P1, KS, qr, r32, hi); } while (0)
#define DECIDE(P0, P1, MN, AL) do { if constexpr (MI) decide_mi(P0, P1, minit, Mref, AL, thr2, false); else decideSM(P0, P1, m_reg, MN, AL, C, thr); } while (0)
#define PVSM(VB, P0, P1, MN) do { if constexpr (MI) pv_mi(o, VB, pa0, pa1, pa2, pa3, P0); else pv_sm(o, VB, pa0, pa1, pa2, pa3, P0, P1, C, MN); } while (0)
  SLOAD(SE, 0); asm volatile("s_waitcnt vmcnt(0)" ::: "memory"); SWRITE(0, SE); __syncthreads();
  if constexpr (MI) { qkt_mi<NQK>(pA0, pA1, K_lds, qr, r32, hi, minit); decide_mi(pA0, pA1, minit, Mref, alA, thr2, true);
#pragma unroll
    for (int r = 0; r < 16; ++r) pA0[r] = __builtin_amdgcn_exp2f(pA0[r]); }
  else { qkt<NQK>(pA0, pA1, K_lds, qr, r32, hi); partialSM(pA0, pA1, m_reg, mnA, alA, C, thr); }
  SLOAD(SO, 64); if constexpr (SD == 2) { if (2 < NT) SLOAD(SE, 2 * 64); }
  SWAIT(); SWRITE(1, SO); __syncthreads();
  int rp = 0, rc = 1, rn = 2;
#define ROT() do { const int _r = rp; rp = rc; rc = rn; rn = _r; } while (0)
  for (int j = 1; j + 1 < NT; j += 2) {
    SBAR(); QKT(pB0, pB1, K_lds + rc * KT);
    finishSM(pA0, pA1, alA, l_reg, pa0, pa1, pa2, pa3); DECIDE(pB0, pB1, mnB, alB); SBAR();
    SLOAD(SO, (j + SD) * 64); SBAR();
    PVSM(vb0 + rp * SHM_V, pB0, pB1, mnB);
    SWAIT(); SWRITE(rn, SE);
    RESC(alB); __syncthreads(); ROT();
    SBAR(); QKT(pA0, pA1, K_lds + rc * KT);
    finishSM(pB0, pB1, alB, l_reg, pa0, pa1, pa2, pa3); DECIDE(pA0, pA1, mnA, alA); SBAR();
    if (SD == 1 || j + 3 < NT) SLOAD(SE, (j + 1 + SD) * 64); SBAR();
    PVSM(vb0 + rp * SHM_V, pA0, pA1, mnA);
    SWAIT(); SWRITE(rn, SO);
    RESC(alA); __syncthreads(); ROT();
  }
  SBAR(); QKT(pB0, pB1, K_lds + rc * KT);
  finishSM(pA0, pA1, alA, l_reg, pa0, pa1, pa2, pa3); DECIDE(pB0, pB1, mnB, alB); SBAR();
  PVSM(vb0 + rp * SHM_V, pB0, pB1, mnB);
  RESC(alB);
  finishSM(pB0, pB1, alB, l_reg, pa0, pa1, pa2, pa3); SBAR();
  pv_d0(o, vb0 + rc * SHM_V, pa0, pa1, pa2, pa3);
#undef QKT
#undef DECIDE
#undef PVSM
#undef ROT
  if (hi == 0) li_l[r32] = l_reg; asm volatile("s_waitcnt lgkmcnt(0)" ::: "memory");
  float rli[16];
#pragma unroll
  for (int r = 0; r < 16; ++r) rli[r] = __builtin_amdgcn_rcpf(li_l[crow(r, hi)]);
  bf16_t* Ow = Ob + (long)(wid * 32) * ldo;
#pragma unroll
  for (int r = 0; r < 16; ++r) { const int orow = crow(r, hi);
#pragma unroll
    for (int d0 = 0; d0 < 4; ++d0) Ow[(long)orow * ldo + d0 * 32 + r32] = f2bf(o[d0][r] * rli[r]); }
  asm volatile("s_waitcnt vmcnt(0)" ::: "memory");
  __builtin_amdgcn_s_setprio(0);
  __syncthreads();
#undef STG_T
#undef VOFFV
#undef VSTV
#undef VOFFK
#undef LDSK
#undef SLOAD
#undef SWRITE
#undef SWAIT
#undef RESC
}

__device__ __forceinline__ void conv_matrix(const float* __restrict__ src, int K, int N, int Npad, bf16_t* __restrict__ dst, const float* __restrict__ scale, float* tile) {
  const int nk = K / 64, nn = Npad / 64, tot = nk * nn;
  const int tid = tid_(), tx = tid & 63, ty = tid >> 6, nl = tid >> 3, ks = (tid & 7) * 8;
  for (int i0 = blockIdx.x; i0 < tot; i0 += 2 * gridDim.x) {
    const int i1 = i0 + gridDim.x; const bool has1 = i1 < tot;
    const int k0a = (i0 % nk) * 64, n0a = (i0 / nk) * 64, k0b = has1 ? (i1 % nk) * 64 : 0, n0b = has1 ? (i1 / nk) * 64 : 0;
    float va[8], vb[8];
#pragma unroll
    for (int i = 0; i < 8; ++i) { const int k = k0a + ty + 8 * i, n = n0a + tx; float v = (n < N) ? src[(size_t)k * N + n] : 0.f; if (scale) v *= scale[k]; va[i] = v; }
    if (has1) {
#pragma unroll
      for (int i = 0; i < 8; ++i) { const int k = k0b + ty + 8 * i, n = n0b + tx; float v = (n < N) ? src[(size_t)k * N + n] : 0.f; if (scale) v *= scale[k]; vb[i] = v; }
    }
    __syncthreads();
#pragma unroll
    for (int i = 0; i < 8; ++i) { tile[(ty + 8 * i) * 65 + tx] = va[i]; if (has1) tile[4160 + (ty + 8 * i) * 65 + tx] = vb[i]; }
    __syncthreads();
    { float v[8];
#pragma unroll
      for (int j = 0; j < 8; ++j) v[j] = tile[(ks + j) * 65 + nl];
      u32x4 w = {cvt_pk_bf16(v[0], v[1]), cvt_pk_bf16(v[2], v[3]), cvt_pk_bf16(v[4], v[5]), cvt_pk_bf16(v[6], v[7])};
      *(u32x4*)(dst + (size_t)(n0a + nl) * K + k0a + ks) = w; }
    if (has1) { float v[8];
#pragma unroll
      for (int j = 0; j < 8; ++j) v[j] = tile[4160 + (ks + j) * 65 + nl];
      u32x4 w = {cvt_pk_bf16(v[0], v[1]), cvt_pk_bf16(v[2], v[3]), cvt_pk_bf16(v[4], v[5]), cvt_pk_bf16(v[6], v[7])};
      *(u32x4*)(dst + (size_t)(n0b + nl) * K + k0b + ks) = w; }
  }
}

__device__ __forceinline__ void norm_phase(float* __restrict__ X, bf16_t* __restrict__ H, const float* __restrict__ nw, const float* __restrict__ modL, const float* __restrict__ modC, int sh_off, int sc_off,
                                           const float* __restrict__ part, int nsl, const float* __restrict__ latsrc, const float* __restrict__ ctxsrc) {
  const int tid = tid_(); const int wid = tid >> 6, lane = tid & 63;
  const int stride = gridDim.x * 8;
  int r = blockIdx.x * 8 + wid;
  f32x4 nx[4];
#define NSRC(rr) ((rr) < NCTX ? (ctxsrc ? ctxsrc + (size_t)(rr) * DM : X + (size_t)(rr) * DM) : (latsrc ? latsrc + (size_t)((rr) - NCTX) * DM : X + (size_t)(rr) * DM))
  if (r < T_TOK) { const float* sp = NSRC(r);
#pragma unroll
    for (int i = 0; i < 4; ++i) nx[i] = *(const f32x4*)(sp + i * 256 + lane * 4);
  }
  for (; r < T_TOK; r += stride) {
    float* xr = X + (size_t)r * DM; f32x4 v[4]; float ss = 0.f;
#pragma unroll
    for (int i = 0; i < 4; ++i) v[i] = nx[i];
    const int rn = r + stride;
    if (rn < T_TOK) { const float* sp = NSRC(rn);
#pragma unroll
      for (int i = 0; i < 4; ++i) nx[i] = *(const f32x4*)(sp + i * 256 + lane * 4);
    }
    if (r < NCTX && nsl > 0) {
      for (int sl = 0; sl < nsl; ++sl) { const float* pr = part + ((size_t)sl * NCTX + r) * DM;
#pragma unroll
        for (int i = 0; i < 4; ++i) v[i] += *(const f32x4*)(pr + i * 256 + lane * 4); }
#pragma unroll
      for (int i = 0; i < 4; ++i) *(f32x4*)(xr + i * 256 + lane * 4) = v[i];
    }
#pragma unroll
    for (int i = 0; i < 4; ++i) ss += v[i][0] * v[i][0] + v[i][1] * v[i][1] + v[i][2] * v[i][2] + v[i][3] * v[i][3];
    ss = wave_sum(ss); const float rstd = rsqrtf(ss * (1.f / DM) + EPSN);
    const float* md = r < NCTX ? modC : modL;
#pragma unroll
    for (int i = 0; i < 4; ++i) { const int col = i * 256 + lane * 4; const f32x4 w = *(const f32x4*)(nw + col), sc = *(const f32x4*)(md + sc_off + col), sh = *(const f32x4*)(md + sh_off + col);
      f32x4 h; for (int j = 0; j < 4; ++j) h[j] = (v[i][j] * rstd) * w[j] * (1.f + sc[j]) + sh[j];
      store_bf16x4(H + (size_t)r * DM + col, h); }
  }
}
#undef NSRC

__device__ __forceinline__ float rope_lane(float x, int lane, int t, const float* __restrict__ ROPE) {
  const int ax = lane >> 5, i = lane & 15, pos = ax ? (t & 63) : (t >> 6);
  const float cs = ROPE[pos * 32 + i * 2], sn = ROPE[pos * 32 + i * 2 + 1];
  const float pr = __shfl_xor(x, 16, 64);
  return (lane & 16) ? (x * cs + pr * sn) : (x * cs - pr * sn);
}

__device__ __forceinline__ void mla_prep(const bf16_t* __restrict__ U, const bf16_t* __restrict__ CQ, bf16_t* __restrict__ Qa, bf16_t* __restrict__ Ka, bf16_t* __restrict__ Va,
                                         const float* __restrict__ qkq, const float* __restrict__ qkk, const float* __restrict__ ROPE) {
  const int tid = tid_(); const int wid = tid >> 6, lane = tid & 63;
  const float wq0 = qkq[lane], wq1 = qkq[64 + lane], wq2 = qkq[128 + lane], wk0 = qkk[lane], wk1 = qkk[64 + lane], wk2 = qkk[128 + lane];
  auto do_row = [&](const int r) {
    const bf16_t* cq = CQ + (size_t)r * 768; float sq = 0.f, skv = 0.f;
#pragma unroll
    for (int i = 0; i < 6; ++i) { const float x = bf2f(cq[i * 64 + lane]); sq += x * x; }
#pragma unroll
    for (int i = 0; i < 4; ++i) { const float x = bf2f(cq[384 + i * 64 + lane]); skv += x * x; }
    sq = wave_sum(sq); skv = wave_sum(skv);
    const float rq = rsqrtf(sq * (1.f / 384.f) + EPSN), rkv = rsqrtf(skv * (1.f / 256.f) + EPSN);
    const float kr = bf2f(cq[640 + lane]);
    const bool lat = r >= NCTX; const int t = r - NCTX;
    const bf16_t* u = U + (size_t)r * 1792;
#pragma unroll
    for (int h = 0; h < 4; ++h) {
      float q0 = bf2f(u[h * 192 + lane]) * rq, q1 = bf2f(u[h * 192 + 64 + lane]) * rq, q2 = bf2f(u[h * 192 + 128 + lane]) * rq;
      float ss = wave_sum(q0 * q0 + q1 * q1 + q2 * q2); float rs = rsqrtf(ss * (1.f / 192.f) + EPSN);
      q0 = q0 * rs * wq0; q1 = q1 * rs * wq1; q2 = q2 * rs * wq2; if (lat) q2 = rope_lane(q2, lane, t, ROPE);
      bf16_t* qo = Qa + (size_t)r * 768 + h * 192; qo[lane] = f2bf(q0); qo[64 + lane] = f2bf(q1); qo[128 + lane] = f2bf(q2);
      const bf16_t* kv = u + 768 + h * 256;
      float k0 = bf2f(kv[lane]) * rkv, k1 = bf2f(kv[64 + lane]) * rkv; const float v0 = bf2f(kv[128 + lane]) * rkv, v1 = bf2f(kv[192 + lane]) * rkv;
      ss = wave_sum(k0 * k0 + k1 * k1 + kr * kr); rs = rsqrtf(ss * (1.f / 192.f) + EPSN);
      k0 = k0 * rs * wk0; k1 = k1 * rs * wk1; float k2 = kr * rs * wk2; if (lat) k2 = rope_lane(k2, lane, t, ROPE);
      bf16_t* ko = Ka + (size_t)r * 768 + h * 192; ko[lane] = f2bf(k0); ko[64 + lane] = f2bf(k1); ko[128 + lane] = f2bf(k2);
      bf16_t* vo = Va + (size_t)r * 512 + h * 128; vo[lane] = f2bf(v0); vo[64 + lane] = f2bf(v1);
    }
    };
  const int stride = gridDim.x * 8;
  for (int r = blockIdx.x * 8 + wid; r < T_TOK; r += 2 * stride) { do_row(r); if (r + stride < T_TOK) do_row(r + stride); }
}
__device__ __forceinline__ void diff_prep(bf16_t* __restrict__ DQK, const float* __restrict__ wq, const float* __restrict__ wk, const float* __restrict__ ROPE) {
  const int tid = tid_(); const int wid = tid >> 6, lane = tid & 63; const float w_q = wq[lane], w_k = wk[lane];
  const int stride = gridDim.x * 8;
  for (int r0 = blockIdx.x * 8 + wid; r0 < T_TOK; r0 += 2 * stride) {
    const int r1 = r0 + stride; const bool has1 = r1 < T_TOK;
    bf16_t* p0 = DQK + (size_t)r0 * 1024; bf16_t* p1 = DQK + (size_t)(has1 ? r1 : r0) * 1024;
    float x0[16], x1[16];
#pragma unroll
    for (int g = 0; g < 16; ++g) { x0[g] = bf2f(p0[g * 64 + lane]); x1[g] = bf2f(p1[g * 64 + lane]); }
#pragma unroll
    for (int g = 0; g < 16; ++g) {
      const float s0 = wave_sum(x0[g] * x0[g]), s1 = wave_sum(x1[g] * x1[g]);
      float y0 = x0[g] * rsqrtf(s0 * (1.f / 64.f) + EPSN) * (g < 8 ? w_q : w_k), y1 = x1[g] * rsqrtf(s1 * (1.f / 64.f) + EPSN) * (g < 8 ? w_q : w_k);
      if (r0 >= NCTX) y0 = rope_lane(y0, lane, r0 - NCTX, ROPE);
      if (r1 >= NCTX) y1 = rope_lane(y1, lane, r1 - NCTX, ROPE);
      p0[g * 64 + lane] = f2bf(y0); if (has1) p1[g * 64 + lane] = f2bf(y1);
    }
  }
}
__device__ __forceinline__ void rec_combine(const bf16_t* __restrict__ OF, const bf16_t* __restrict__ OBk, const bf16_t* __restrict__ gate, const float* __restrict__ nw, bf16_t* __restrict__ Y, int coff) {
  const int tid = tid_(); const int wid = tid >> 6, lane = tid & 63; const float w0 = nw[lane], w1 = nw[64 + lane];
  const int stride = gridDim.x * 8;
  for (int r0 = blockIdx.x * 8 + wid; r0 < T_TOK; r0 += 2 * stride)
#pragma unroll
  for (int rr = 0; rr < 2; ++rr) { const int r = r0 + rr * stride; if (r >= T_TOK) break;
#pragma unroll
    for (int h = 0; h < 4; ++h) { const size_t b = (size_t)r * 512 + h * 128 + lane;
      const float a0 = bf2f(OF[b]) + bf2f(OBk[b]), a1 = bf2f(OF[b + 64]) + bf2f(OBk[b + 64]);
      const float ss = wave_sum(a0 * a0 + a1 * a1); const float rs = rsqrtf(ss * (1.f / 128.f) + EPSN);
      bf16_t* yo = Y + (size_t)r * DM + coff + h * 128 + lane; yo[0] = f2bf(a0 * rs * w0 * bf2f(gate[b])); yo[64] = f2bf(a1 * rs * w1 * bf2f(gate[b + 64])); }
  }
}
__device__ __forceinline__ void diff_combine(const bf16_t* __restrict__ OD, const float* __restrict__ subln, float lam, float one_m_li, bf16_t* __restrict__ Y) {
  const int tid = tid_(); const int wid = tid >> 6, lane = tid & 63; const float w0 = subln[lane] * one_m_li, w1 = subln[64 + lane] * one_m_li;
  for (int r = blockIdx.x * 8 + wid; r < T_TOK; r += gridDim.x * 8) {
#pragma unroll
    for (int h = 0; h < 4; ++h) { const bf16_t* o1 = OD + (size_t)r * 1024 + h * 256 + lane; const bf16_t* o2 = o1 + 128;
      const float a0 = bf2f(o1[0]) - lam * bf2f(o2[0]), a1 = bf2f(o1[64]) - lam * bf2f(o2[64]);
      const float ss = wave_sum(a0 * a0 + a1 * a1); const float rs = rsqrtf(ss * (1.f / 128.f) + EPSN);
      bf16_t* yo = Y + (size_t)r * DM + h * 128 + lane; yo[0] = f2bf(a0 * rs * w0); yo[64] = f2bf(a1 * rs * w1); }
  }
}

__device__ __forceinline__ int rowmap(int d, int p) { return d == 0 ? p : (p < NCTX ? (NCTX - 1 - p) : (T_TOK + NCTX - 1 - p)); }
#define WAVE_LDS_SYNC() do { __builtin_amdgcn_fence(__ATOMIC_RELEASE, "workgroup"); __builtin_amdgcn_wave_barrier(); __builtin_amdgcn_fence(__ATOMIC_ACQUIRE, "workgroup"); } while (0)
template <int KD, int PASS>
__device__ __forceinline__ void rec_pass(const float* __restrict__ Ag, const float* __restrict__ Bg, const bf16_t* __restrict__ Vg, float* __restrict__ Sbuf, float* __restrict__ DL,
                                         bf16_t* __restrict__ OUT, const float* __restrict__ rt_decay_j, char* lds) {
  constexpr bool HG = (KD == 128); constexpr int KH = KD / 2, NB = 10, C4 = KH / 4, RPL = 64 / C4, NLD = (NB + RPL - 1) / RPL;
  constexpr int ldA = HG ? 1024 : 256, ldB = HG ? 512 : 256;
  constexpr int WSZ = 2 * NB * KH + NB * 64;
  const int tid = tid_(); const int wid = __builtin_amdgcn_readfirstlane(tid >> 6), lane = tid & 63;
  float* sA = (float*)lds + wid * WSZ; float* sB = sA + NB * KH; float* sV = sB + NB * KH;
  float* sR = (float*)lds + 8 * WSZ + (wid >> 1) * (2 * NB * 64);
  const int lrow = lane / C4, lc4 = lane % C4;
  for (int it = blockIdx.x * 8 + wid; it < NSC * 32; it += gridDim.x * 8) {
    const int kh = it & 1, vh = (it >> 1) & 1, d = (it >> 2) & 1, h = (it >> 3) & 3, sc = it >> 5, hd = h * 2 + d;
    const float* Abase = Ag + (HG ? (d * 512 + h * 128) : (h * 64)) + kh * KH;
    const float* Bbase = Bg + (HG ? (h * 128) : (h * 64)) + kh * KH;
    const bf16_t* Vbase = Vg + h * 128 + vh * 64 + lane;
    float gam = 0.f; if (!HG) gam = sigmoidf_(rt_decay_j[d * 4 + h]);
    f32x2 S2[KH / 2];
    float* Sg = Sbuf + ((size_t)(sc * 8 + hd) * KD + kh * KH) * 128 + vh * 64 + lane;
    if (PASS == 1) {
#pragma unroll
      for (int k = 0; k < KH / 2; ++k) S2[k] = (f32x2){0.f, 0.f};
    } else {
#pragma unroll
      for (int k = 0; k < KH / 2; ++k) S2[k] = (f32x2){Sg[(size_t)(2 * k) * 128], Sg[(size_t)(2 * k + 1) * 128]};
    }
    const f32x2 gam2 = {gam, gam};
    float dp = 1.f;
    const int p0 = sc * LSC;
    f32x4 la[NLD], lb[NLD]; float lv[NB];
#define REC_LOAD(pb) do { _Pragma("unroll") for (int jj = 0; jj < NLD; ++jj) { const int lr = jj * RPL + lrow; if (lr < NB) { const int rr = rowmap(d, (pb) + lr); \
        la[jj] = *(const f32x4*)(Abase + (size_t)rr * ldA + lc4 * 4); if (PASS == 3) lb[jj] = *(const f32x4*)(Bbase + (size_t)rr * ldB + lc4 * 4); } } \
      _Pragma("unroll") for (int i = 0; i < NB; ++i) lv[i] = bf2f(Vbase[(size_t)rowmap(d, (pb) + i) * 512]); } while (0)
    REC_LOAD(p0);
    for (int bt = 0; bt < LSC / NB; ++bt) {
      const int pb = p0 + bt * NB;
#pragma unroll
      for (int i = 0; i < NB; ++i) sV[i * 64 + lane] = lv[i];
#pragma unroll
      for (int jj = 0; jj < NLD; ++jj) { const int lr = jj * RPL + lrow; if (lr < NB) { *(f32x4*)(sA + lr * KH + lc4 * 4) = la[jj]; if (PASS == 3) *(f32x4*)(sB + lr * KH + lc4 * 4) = lb[jj]; } }
      WAVE_LDS_SYNC();
      if (bt + 1 < LSC / NB) REC_LOAD(pb + NB);
      {
        constexpr int NG = KH / 16;
        f32x4 ca[4], cb[4], na[4], nb[4];
#define LOADG(A_, B_, i_, g_) do { _Pragma("unroll") for (int q_ = 0; q_ < 4; ++q_) { A_[q_] = *(const f32x4*)(sA + (i_) * KH + (g_) * 16 + q_ * 4); \
          if (PASS == 3) B_[q_] = *(const f32x4*)(sB + (i_) * KH + (g_) * 16 + q_ * 4); } } while (0)
#define COMPG(A_, B_, g_) do { _Pragma("unroll") for (int q_ = 0; q_ < 4; ++q_) _Pragma("unroll") for (int e_ = 0; e_ < 2; ++e_) { const int kk_ = (g_) * 8 + q_ * 2 + e_; \
          const f32x2 a2 = {A_[q_][2 * e_], A_[q_][2 * e_ + 1]}; f32x2 s2 = S2[kk_]; \
          if (HG) s2 = a2 * (s2 - vv) + vv; else s2 = gam2 * s2 + a2 * vv; S2[kk_] = s2; \
          if (PASS == 3) { const f32x2 b2 = {B_[q_][2 * e_], B_[q_][2 * e_ + 1]}; if (e_ == 0) o2a += b2 * s2; else o2b += b2 * s2; } } } while (0)
        LOADG(ca, cb, 0, 0);
#pragma unroll 1
        for (int i = 0; i < NB; ++i) {
          const float v = sV[i * 64 + lane]; const f32x2 vv = {v, v}; f32x2 o2a = {0.f, 0.f}, o2b = {0.f, 0.f};
          if (HG && PASS == 1) dp *= sA[i * KH + lane];
#pragma unroll
          for (int g = 0; g < NG; g += 2) {
            LOADG(na, nb, i, g + 1); COMPG(ca, cb, g);
            if (g + 2 < NG) LOADG(ca, cb, i, g + 2); else LOADG(ca, cb, i + 1, 0);
            COMPG(na, nb, g + 1);
          }
          if (PASS == 3) { const f32x2 o2 = o2a + o2b; sR[(kh * NB + i) * 64 + lane] = o2[0] + o2[1]; }
        }
#undef LOADG
#undef COMPG
      }
      if (PASS == 3) {
        __syncthreads();
        if (kh == 0) {
#pragma unroll
          for (int i = 0; i < NB; ++i) OUT[(size_t)d * T_TOK * 512 + (size_t)rowmap(d, pb + i) * 512 + h * 128 + vh * 64 + lane] = f2bf(sR[i * 64 + lane] + sR[(NB + i) * 64 + lane]);
        }
        __syncthreads();
      } else { WAVE_LDS_SYNC(); }
    }
#undef REC_LOAD
    if (PASS == 1) {
#pragma unroll
      for (int k = 0; k < KH / 2; ++k) { Sg[(size_t)(2 * k) * 128] = S2[k][0]; Sg[(size_t)(2 * k + 1) * 128] = S2[k][1]; }
      if (HG && vh == 0) DL[(size_t)(sc * 8 + hd) * 128 + kh * 64 + lane] = dp;
    }
  }
}

#define LDS_BARRIER() do { asm volatile("s_waitcnt lgkmcnt(0)" ::: "memory"); __builtin_amdgcn_s_barrier(); asm volatile("" ::: "memory"); } while (0)
typedef __bf16 bf16x2_t __attribute__((ext_vector_type(2)));
__device__ __forceinline__ unsigned cvt2(float lo, float hi) { const f32x2 v = {lo, hi}; const bf16x2_t r = __builtin_convertvector(v, bf16x2_t); return __builtin_bit_cast(unsigned, r); }
__device__ __forceinline__ bf16_t f2bf2(float f) { return (bf16_t)(cvt2(f, 0.f) & 0xffffu); }
__device__ __forceinline__ bf16x8 mk8(u32x2 lo, u32x2 hi) { u32x4 w = {lo.x, lo.y, hi.x, hi.y}; return *reinterpret_cast<bf16x8*>(&w); }
template <int PASS>
__device__ __forceinline__ void hg_mfma_pass(const float* __restrict__ Fg, const bf16_t* __restrict__ Qg, const bf16_t* __restrict__ Vg, float* __restrict__ Sbuf, float* __restrict__ DL,
                                             bf16_t* __restrict__ OUT, char* lds) {
  constexpr int CH = 16, NCH = (LSC + CH - 1) / CH, QROW = 272;
  const int tid = tid_(); const int hb = tid >> 8, th_ = tid & 255, k = th_ & 127, th = th_ >> 7, lane = tid & 63, w = (tid >> 6) & 3, r16 = lane & 15, fq = lane >> 4;
  char* base = lds + hb * 32768;
  float* sSum = (float*)base;
  float* sD = (float*)(base + 1024);
  char* sQ = base + 2048;
  char* sK = sQ + 16 * QROW;
  bf16_t* sKT = (bf16_t*)(sK + 16 * QROW);
  bf16_t* sVT = sKT + 128 * 16;
  for (int it = blockIdx.x * 2 + hb; it < NSC * 8; it += gridDim.x * 2) {
    const int sc = it >> 3, hd = it & 7, h = hd >> 1, d = hd & 1;
    const float* Fb = Fg + d * 512 + h * 128 + k; const bf16_t* Qb = Qg + h * 128 + k; const bf16_t* Vb = Vg + h * 128 + k;
    f32x4 S[8][2];
    float* Sg = Sbuf + ((size_t)(sc * 8 + hd) * 128) * 128 + w * 32 + r16;
#pragma unroll
    for (int kt = 0; kt < 8; ++kt)
#pragma unroll
      for (int vt = 0; vt < 2; ++vt)
#pragma unroll
        for (int j = 0; j < 4; ++j) S[kt][vt][j] = (PASS == 1) ? 0.f : Sg[(size_t)(16 * kt + 4 * fq + j) * 128 + vt * 16];
    float dprod = 1.f;
    const int p0 = sc * LSC;
    float lf[8], lq[8], lv[8];
#define HG_LOAD(c_) do { _Pragma("unroll") for (int i = 0; i < 8; ++i) { const int tt = (c_) * CH + 8 * th + i; \
      if (tt < LSC) { const int rr = rowmap(d, p0 + tt); lf[i] = Fb[(size_t)rr * 1024]; lv[i] = bf2f(Vb[(size_t)rr * 512]); if (PASS == 3) lq[i] = bf2f(Qb[(size_t)rr * 512]); else lq[i] = 0.f; } \
      else { lf[i] = 1.f; lv[i] = 0.f; lq[i] = 0.f; } } } while (0)
    HG_LOAD(0);
    for (int c = 0; c < NCH; ++c) {
      float f8[8], q8[8], v8[8], b8[8];
#pragma unroll
      for (int i = 0; i < 8; ++i) { f8[i] = lf[i]; q8[i] = lq[i]; v8[i] = lv[i]; }
      float run = 0.f;
#pragma unroll
      for (int i = 0; i < 8; ++i) { run += fmaxf(__logf(f8[i]), -60.f); b8[i] = run; }
      sSum[th * 128 + k] = run;
      LDS_BARRIER();
      const float s0 = sSum[k], s1 = sSum[128 + k], blast = s0 + s1, boff = th ? s0 : 0.f;
      unsigned kh[4], vv[4];
#pragma unroll
      for (int i = 0; i < 8; i += 2) {
        float qt[2], kt_[2], khh[2];
#pragma unroll
        for (int e = 0; e < 2; ++e) { const float b = b8[i + e] + boff, omf = 1.f - f8[i + e];
          qt[e] = q8[i + e] * __expf(b); kt_[e] = omf * __expf(fminf(-b, 85.f)); khh[e] = omf * __expf(blast - b); }
        if (PASS == 3) { *(bf16_t*)(sQ + (8 * th + i) * QROW + k * 2) = f2bf2(qt[0]); *(bf16_t*)(sQ + (8 * th + i + 1) * QROW + k * 2) = f2bf2(qt[1]);
                         *(bf16_t*)(sK + (8 * th + i) * QROW + k * 2) = f2bf2(kt_[0]); *(bf16_t*)(sK + (8 * th + i + 1) * QROW + k * 2) = f2bf2(kt_[1]); }
        kh[i >> 1] = cvt2(khh[0], khh[1]); vv[i >> 1] = cvt2(v8[i], v8[i + 1]);
      }
      *(u32x4*)(sKT + k * 16 + 8 * th) = (u32x4){kh[0], kh[1], kh[2], kh[3]};
      *(u32x4*)(sVT + k * 16 + 8 * th) = (u32x4){vv[0], vv[1], vv[2], vv[3]};
      if (th == 0) { const float dk = __expf(blast); sD[k] = dk; dprod *= dk; }
      if (c + 1 < NCH) HG_LOAD(c + 1);
      LDS_BARRIER();
      bf16x8 VT[2];
#pragma unroll
      for (int vt = 0; vt < 2; ++vt) VT[vt] = mk8(*(const u32x2*)(sVT + (w * 32 + vt * 16 + r16) * 16 + 4 * fq), (u32x2){0u, 0u});
      if (PASS == 3) {
        bf16x8 Qp[4]; f32x4 A = {0.f, 0.f, 0.f, 0.f};
#pragma unroll
        for (int j = 0; j < 4; ++j) {
          const char* qa = sQ + r16 * QROW + (32 * j + 4 * fq) * 2; const char* ka = sK + r16 * QROW + (32 * j + 4 * fq) * 2;
          Qp[j] = mk8(*(const u32x2*)qa, *(const u32x2*)(qa + 32));
          const bf16x8 Kp = mk8(*(const u32x2*)ka, *(const u32x2*)(ka + 32));
          A = __builtin_amdgcn_mfma_f32_16x16x32_bf16(Kp, Qp[j], A, 0, 0, 0);
        }
#pragma unroll
        for (int jj = 0; jj < 4; ++jj) A[jj] = (4 * fq + jj <= r16) ? A[jj] : 0.f;
        const bf16x8 Af = mk8((u32x2){cvt2(A[0], A[1]), cvt2(A[2], A[3])}, (u32x2){0u, 0u});
#pragma unroll
        for (int vt = 0; vt < 2; ++vt) {
          f32x4 O = {0.f, 0.f, 0.f, 0.f};
          O = __builtin_amdgcn_mfma_f32_16x16x32_bf16(Af, VT[vt], O, 0, 0, 0);
#pragma unroll
          for (int j = 0; j < 4; ++j) {
            const bf16x8 Sf = mk8((u32x2){cvt2(S[2 * j][vt][0], S[2 * j][vt][1]), cvt2(S[2 * j][vt][2], S[2 * j][vt][3])},
                                  (u32x2){cvt2(S[2 * j + 1][vt][0], S[2 * j + 1][vt][1]), cvt2(S[2 * j + 1][vt][2], S[2 * j + 1][vt][3])});
            O = __builtin_amdgcn_mfma_f32_16x16x32_bf16(Qp[j], Sf, O, 0, 0, 0);
          }
#pragma unroll
          for (int jj = 0; jj < 4; ++jj) { const int tt = c * CH + 4 * fq + jj;
            if (tt < LSC) OUT[(size_t)d * T_TOK * 512 + (size_t)rowmap(d, p0 + tt) * 512 + h * 128 + w * 32 + vt * 16 + r16] = f2bf2(O[jj]); }
        }
      }
#pragma unroll
      for (int kt = 0; kt < 8; ++kt) {
        const bf16x8 KTf = mk8(*(const u32x2*)(sKT + (16 * kt + r16) * 16 + 4 * fq), (u32x2){0u, 0u});
        const f32x4 dk4 = *(const f32x4*)(sD + 16 * kt + 4 * fq);
#pragma unroll
        for (int vt = 0; vt < 2; ++vt) S[kt][vt] = __builtin_amdgcn_mfma_f32_16x16x32_bf16(KTf, VT[vt], S[kt][vt] * dk4, 0, 0, 0);
      }
    }
#undef HG_LOAD
    if (PASS == 1) {
#pragma unroll
      for (int kt = 0; kt < 8; ++kt)
#pragma unroll
        for (int vt = 0; vt < 2; ++vt)
#pragma unroll
          for (int j = 0; j < 4; ++j) Sg[(size_t)(16 * kt + 4 * fq + j) * 128 + vt * 16] = S[kt][vt][j];
      if (th == 0) DL[(size_t)(sc * 8 + hd) * 128 + k] = dprod;
    }
    __syncthreads();
  }
}


template <int PASS>
__device__ __forceinline__ void rt_mfma_pass(const float* __restrict__ Kg, const float* __restrict__ Qg, const bf16_t* __restrict__ Vg, float* __restrict__ Sbuf,
                                             bf16_t* __restrict__ OUT, const float* __restrict__ rt_decay_j, char* lds) {
  constexpr int CH = 16, NCH = (LSC + CH - 1) / CH, QROW = 144;
  const int tid = tid_(); const int hb = tid >> 8, th_ = tid & 255, kq = th_ & 63, tq = th_ >> 6, vcol = th_ & 127, th = th_ >> 7, lane = tid & 63, w = (tid >> 6) & 3, r16 = lane & 15, fq = lane >> 4;
  char* base = lds + hb * 32768;
  char* sQ = base;
  char* sK = sQ + 16 * QROW;
  bf16_t* sKT = (bf16_t*)(sK + 16 * QROW);
  bf16_t* sVT = sKT + 64 * 16;
  for (int it = blockIdx.x * 2 + hb; it < NSC * 8; it += gridDim.x * 2) {
    const int sc = it >> 3, hd = it & 7, h = hd >> 1, d = hd & 1;
    const float lg = -log1pf(expf(-rt_decay_j[d * 4 + h]));
    const float* Kb = Kg + h * 64 + kq; const float* Qb = Qg + h * 64 + kq; const bf16_t* Vb = Vg + h * 128 + vcol;
    f32x4 S[4][2];
    float* Sg = Sbuf + ((size_t)(sc * 8 + hd) * 64) * 128 + w * 32 + r16;
#pragma unroll
    for (int kt = 0; kt < 4; ++kt)
#pragma unroll
      for (int vt = 0; vt < 2; ++vt)
#pragma unroll
        for (int j = 0; j < 4; ++j) S[kt][vt][j] = (PASS == 1) ? 0.f : Sg[(size_t)(16 * kt + 4 * fq + j) * 128 + vt * 16];
    const int p0 = sc * LSC;
    float lk[4], lq[4], lv[8];
#define RT_LOAD(c_) do { _Pragma("unroll") for (int i = 0; i < 4; ++i) { const int tt = (c_) * CH + 4 * tq + i; \
      if (tt < LSC) { const int rr = rowmap(d, p0 + tt); lk[i] = Kb[(size_t)rr * 256]; if (PASS == 3) lq[i] = Qb[(size_t)rr * 256]; else lq[i] = 0.f; } else { lk[i] = 0.f; lq[i] = 0.f; } } \
      _Pragma("unroll") for (int i = 0; i < 8; ++i) { const int tt = (c_) * CH + 8 * th + i; lv[i] = (tt < LSC) ? bf2f(Vb[(size_t)rowmap(d, p0 + tt) * 512]) : 0.f; } } while (0)
    RT_LOAD(0);
    for (int c = 0; c < NCH; ++c) {
      const int nvalid = (LSC - c * CH) < CH ? (LSC - c * CH) : CH;
      const float blast = (float)nvalid * lg, dk = __expf(blast);
      float k4[4], q4[4], v8[8];
#pragma unroll
      for (int i = 0; i < 4; ++i) { k4[i] = lk[i]; q4[i] = lq[i]; }
#pragma unroll
      for (int i = 0; i < 8; ++i) v8[i] = lv[i];
      LDS_BARRIER();
      float khh[4];
#pragma unroll
      for (int i = 0; i < 4; ++i) { const int tl = 4 * tq + i; const float b = (float)((tl + 1) < nvalid ? (tl + 1) : nvalid) * lg;
        if (PASS == 3) { *(bf16_t*)(sQ + tl * QROW + kq * 2) = f2bf2(q4[i] * __expf(b)); *(bf16_t*)(sK + tl * QROW + kq * 2) = f2bf2(k4[i] * __expf(-b)); }
        khh[i] = k4[i] * __expf(blast - b); }
      *(u32x2*)(sKT + kq * 16 + 4 * tq) = (u32x2){cvt2(khh[0], khh[1]), cvt2(khh[2], khh[3])};
      *(u32x4*)(sVT + vcol * 16 + 8 * th) = (u32x4){cvt2(v8[0], v8[1]), cvt2(v8[2], v8[3]), cvt2(v8[4], v8[5]), cvt2(v8[6], v8[7])};
      if (c + 1 < NCH) RT_LOAD(c + 1);
      LDS_BARRIER();
      bf16x8 VT[2];
#pragma unroll
      for (int vt = 0; vt < 2; ++vt) VT[vt] = mk8(*(const u32x2*)(sVT + (w * 32 + vt * 16 + r16) * 16 + 4 * fq), (u32x2){0u, 0u});
      if (PASS == 3) {
        bf16x8 Qp[2]; f32x4 A = {0.f, 0.f, 0.f, 0.f};
#pragma unroll
        for (int j = 0; j < 2; ++j) {
          const char* qa = sQ + r16 * QROW + (32 * j + 4 * fq) * 2; const char* ka = sK + r16 * QROW + (32 * j + 4 * fq) * 2;
          Qp[j] = mk8(*(const u32x2*)qa, *(const u32x2*)(qa + 32));
          const bf16x8 Kp = mk8(*(const u32x2*)ka, *(const u32x2*)(ka + 32));
          A = __builtin_amdgcn_mfma_f32_16x16x32_bf16(Kp, Qp[j], A, 0, 0, 0);
        }
#pragma unroll
        for (int jj = 0; jj < 4; ++jj) A[jj] = (4 * fq + jj <= r16) ? A[jj] : 0.f;
        const bf16x8 Af = mk8((u32x2){cvt2(A[0], A[1]), cvt2(A[2], A[3])}, (u32x2){0u, 0u});
#pragma unroll
        for (int vt = 0; vt < 2; ++vt) {
          f32x4 O = {0.f, 0.f, 0.f, 0.f};
          O = __builtin_amdgcn_mfma_f32_16x16x32_bf16(Af, VT[vt], O, 0, 0, 0);
#pragma unroll
          for (int j = 0; j < 2; ++j) {
            const bf16x8 Sf = mk8((u32x2){cvt2(S[2 * j][vt][0], S[2 * j][vt][1]), cvt2(S[2 * j][vt][2], S[2 * j][vt][3])},
                                  (u32x2){cvt2(S[2 * j + 1][vt][0], S[2 * j + 1][vt][1]), cvt2(S[2 * j + 1][vt][2], S[2 * j + 1][vt][3])});
            O = __builtin_amdgcn_mfma_f32_16x16x32_bf16(Qp[j], Sf, O, 0, 0, 0);
          }
#pragma unroll
          for (int jj = 0; jj < 4; ++jj) { const int tt = c * CH + 4 * fq + jj;
            if (tt < LSC) OUT[(size_t)d * T_TOK * 512 + (size_t)rowmap(d, p0 + tt) * 512 + h * 128 + w * 32 + vt * 16 + r16] = f2bf2(O[jj]); }
        }
      }
#pragma unroll
      for (int kt = 0; kt < 4; ++kt) {
        const bf16x8 KTf = mk8(*(const u32x2*)(sKT + (16 * kt + r16) * 16 + 4 * fq), (u32x2){0u, 0u});
#pragma unroll
        for (int vt = 0; vt < 2; ++vt) S[kt][vt] = __builtin_amdgcn_mfma_f32_16x16x32_bf16(KTf, VT[vt], S[kt][vt] * dk, 0, 0, 0);
      }
    }
#undef RT_LOAD
    if (PASS == 1) {
#pragma unroll
      for (int kt = 0; kt < 4; ++kt)
#pragma unroll
        for (int vt = 0; vt < 2; ++vt)
#pragma unroll
          for (int j = 0; j < 4; ++j) Sg[(size_t)(16 * kt + 4 * fq + j) * 128 + vt * 16] = S[kt][vt][j];
    }
    __syncthreads();
  }
}

template <int KD>
__device__ __forceinline__ void rec_scan(float* __restrict__ Sbuf, const float* __restrict__ DL, const float* __restrict__ rt_decay_j) {
  constexpr bool HG = (KD == 128); constexpr int PER = KD * 128;
  for (int idx = blockIdx.x * 512 + tid_(); idx < 8 * PER; idx += gridDim.x * 512) {
    const int hd = idx / PER, k = (idx / 128) % KD; float run = 0.f; float dsc = 0.f;
    if (!HG) { const float lgm = -log1pf(expf(-rt_decay_j[(hd & 1) * 4 + (hd >> 1)])); dsc = __expf((float)LSC * lgm); }
    float* p = Sbuf + (size_t)hd * PER + (idx % PER);
    for (int s0 = 0; s0 < NSC; s0 += 8) {
      float loc[8], dec[8];
#pragma unroll
      for (int j = 0; j < 8; ++j) { loc[j] = p[(size_t)(s0 + j) * 8 * PER]; dec[j] = HG ? DL[(size_t)((s0 + j) * 8 + hd) * 128 + k] : dsc; }
#pragma unroll
      for (int j = 0; j < 8; ++j) { p[(size_t)(s0 + j) * 8 * PER] = run; run = dec[j] * run + loc[j]; }
    }
  }
}

template <class PT> __device__ __forceinline__ void setup_phase(const PT& P, float* X, float* MOD, float* ROPE, float* LB, float* SCAL, char* lds) {
  const int tid = tid_(), wid = tid >> 6, lane = tid & 63;
  { float* sv = (float*)lds; float* red = sv + 2048;
    for (int i = tid; i < 1024; i += 512) { sv[i] = siluf_(P.c[i]); sv[1024 + i] = siluf_(P.c_ctx[i]); }
    __syncthreads();
    for (int item = blockIdx.x; item < 4 * 96; item += gridDim.x) {
      const int l = item / 96, n = (item % 96) * 64 + lane; float a0 = 0.f, a1 = 0.f;
      const float* w = P.ada_w + ((size_t)l * 1024 + wid * 128) * 6144 + n;
#pragma unroll 8
      for (int k = 0; k < 128; ++k) { const float wv = w[(size_t)k * 6144]; a0 = fmaf(sv[wid * 128 + k], wv, a0); a1 = fmaf(sv[1024 + wid * 128 + k], wv, a1); }
      red[(wid * 2 + 0) * 64 + lane] = a0; red[(wid * 2 + 1) * 64 + lane] = a1;
      __syncthreads();
      if (wid < 2) { float s = P.ada_b[l * 6144 + n];
#pragma unroll
        for (int w8 = 0; w8 < 8; ++w8) s += red[(w8 * 2 + wid) * 64 + lane];
        MOD[((size_t)l * 2 + wid) * 6144 + n] = s; }
      __syncthreads();
    }
  }
  if (blockIdx.x == gridDim.x - 1) {
    for (int i = tid; i < 256 * 16; i += 512) { const int pos = i >> 4, f = i & 15; const float inv = powf(10000.f, -(float)f / 16.f); float s, c; sincosf((float)pos * inv, &s, &c); ROPE[i * 2] = c; ROPE[i * 2 + 1] = s; }
    for (int i = tid; i < 1024; i += 512) { const float b0 = P.hg_lb[i], b1 = P.hg_lb[1024 + i]; LB[i] = 0.f; LB[1024 + i] = 1.f / (1.f + expf(b0 - b1)); }
    if (tid < 2) { const float* lm = P.da_lambda + tid * 256; float s01 = 0.f, s23 = 0.f; for (int i = 0; i < 64; ++i) { s01 += lm[i] * lm[64 + i]; s23 += lm[128 + i] * lm[192 + i]; }
      const float li = 0.8f - 0.6f * expf(-0.3f * (float)(2 * tid + 1)); SCAL[tid * 2] = expf(s01) - expf(s23) + li; SCAL[tid * 2 + 1] = 1.f - li; }
  }
}

#define XB_TMO      128
#define XB_XCNT(j)  (256  + 64 * (j))
#define XB_XSUB(j)  (1280 + 64 * (j))
#define XB_XGEN(j)  (2304 + 64 * (j))
#define XB_TOP      3328
#define XB_TOPGEN   3392
#define XCD_BAR_WORDS 3456
#define XB_SPIN_CAP (1u << 22)
__device__ __forceinline__ unsigned xb_ld(unsigned* p)              { return __hip_atomic_load(p, __ATOMIC_RELAXED, __HIP_MEMORY_SCOPE_AGENT); }
__device__ __forceinline__ unsigned xb_add(unsigned* p, unsigned v) { return __hip_atomic_fetch_add(p, v, __ATOMIC_RELAXED, __HIP_MEMORY_SCOPE_AGENT); }
__device__ __forceinline__ unsigned xb_xcc_id() { return (unsigned)__builtin_amdgcn_s_getreg((3 << 11) | 20) & 0xFu; }
#define XB_SPIN(cond, bar) do { unsigned _sp = 0; while (cond) { __builtin_amdgcn_s_sleep(1); \
    if ((++_sp & 255u) == 0u) { if (xb_ld(&(bar)[XB_TMO])) break; if (_sp > XB_SPIN_CAP) { atomicAdd(&(bar)[XB_TMO], 1u); break; } } } } while (0)
__device__ __forceinline__ void xcd_barrier_complete(unsigned* bar, unsigned x, unsigned& nloc, unsigned& nx) {
  const unsigned G = gridDim.x;
  unsigned sum, cnt, mine, sp = 0u;
  for (;;) {
    sum = 0u; cnt = 0u; mine = 0u;
#pragma unroll
    for (unsigned j = 0; j < 16; ++j) { const unsigned c = xb_ld(&bar[XB_XCNT(j)]); sum += c; cnt += (c > 0u) ? 1u : 0u; mine = (j == x) ? c : mine; }
    if (sum == G) break;
    __builtin_amdgcn_s_sleep(1);
    if ((++sp & 255u) == 0u) { if (xb_ld(&bar[XB_TMO])) break; if (sp > XB_SPIN_CAP) { atomicAdd(&bar[XB_TMO], 1u); break; } }
  }
  nloc = mine > 0u ? mine : 1u; nx = cnt > 0u ? cnt : 1u;
}
__device__ __forceinline__ void grid_sync(unsigned* bar, volatile LAS unsigned* st) {
  asm volatile("s_waitcnt vmcnt(0)" ::: "memory");
  __syncthreads();
  if (threadIdx.x == 0) {
    __builtin_amdgcn_s_waitcnt(0);
    const unsigned x = xb_xcc_id();
    unsigned nloc = st[0], nx = st[1];
    if (nloc == 0u) { xcd_barrier_complete(bar, x, nloc, nx); st[0] = nloc; st[1] = nx; }
    const unsigned old = xb_add(&bar[XB_XSUB(x)], 1u);
    const unsigned gen = old / nloc;
    if (old + 1u == (gen + 1u) * nloc) {
      __builtin_amdgcn_fence(__ATOMIC_RELEASE, "agent");
      asm volatile("s_waitcnt vmcnt(0)" ::: "memory");
      const unsigned og = xb_add(&bar[XB_TOP], 1u);
      const unsigned tg = og / nx;
      if (og + 1u == (tg + 1u) * nx) xb_add(&bar[XB_TOPGEN], 1u);
      else XB_SPIN(xb_ld(&bar[XB_TOPGEN]) == tg, bar);
      __builtin_amdgcn_fence(__ATOMIC_ACQUIRE, "agent");
      xb_add(&bar[XB_XGEN(x)], 1u);
      asm volatile("s_waitcnt vmcnt(0)" ::: "memory");
    } else {
      XB_SPIN(xb_ld(&bar[XB_XGEN(x)]) == gen, bar);
      __builtin_amdgcn_fence(__ATOMIC_ACQUIRE, "agent");
      asm volatile("s_waitcnt vmcnt(0)" ::: "memory");
    }
  }
  __syncthreads();
}

typedef const Params __attribute__((address_space(4))) CParams;
__device__ __forceinline__ const CParams* get_params() {
  auto p = __builtin_amdgcn_kernarg_segment_ptr();
  asm volatile("" : "+s"(p)); return (const CParams*)p;
}
__global__ void __launch_bounds__(512) fwd_megakernel(Params Parg) {
  extern __shared__ __attribute__((aligned(16))) char shm[];
  cg::grid_group grid = cg::this_grid();
#define P (*get_params())
#define WS_ (P.ws)
#define X ((float*)(WS_ + OFF_X))
#define HB ((bf16_t*)(WS_ + OFF_HB))
#define Y ((bf16_t*)(WS_ + OFF_Y))
#define W (WS_ + OFF_W)
#define MOD ((float*)(WS_ + OFF_MOD))
#define ROPE ((float*)(WS_ + OFF_ROPE))
#define LB ((float*)(WS_ + OFF_LB))
#define SCAL ((float*)(WS_ + OFF_SCAL))
#define BAR ((unsigned*)(WS_ + OFF_BAR))
#define D (WS_ + OFF_D)
#define PART ((float*)(WS_ + OFF_PART))
#define GS() grid_sync(BAR, (volatile LAS unsigned*)xb_st)
#define Win ((bf16_t*)(W + W_IN))
#define Wo ((bf16_t*)(W + W_O))
#define W1 ((bf16_t*)(W + W_1))
#define W2 ((bf16_t*)(W + W_2))
#define Wuq ((bf16_t*)(W + W_UQ))
#define Wukv ((bf16_t*)(W + W_UKV))
#define OFb HB
#define OBb (HB + (size_t)T_TOK * 512)
  LAS unsigned char* glds = (LAS unsigned char*)shm;
  __shared__ __attribute__((aligned(16))) unsigned xb_st[4];
  if (threadIdx.x < 4) xb_st[threadIdx.x] = 0u;
  __syncthreads();
  if (threadIdx.x == 0) (void)xb_add(&BAR[XB_XCNT(xb_xcc_id())], 1u);

  for (int rep = 0; rep < REP_MISC; ++rep) { setup_phase(P, X, MOD, ROPE, LB, SCAL, shm); __syncthreads(); }
  if (P.out == nullptr) grid.sync();
  GS();

  for (int l = 0; l < 4; ++l) {
    const bool last = (l == 3), even = (l & 1) == 0; const int j = l >> 1; const int pm0 = last ? 1 : 0;
#define modL (MOD + (size_t)(l * 2 + 0) * 6144)
#define modC (MOD + (size_t)(l * 2 + 1) * 6144)
    for (int rep = 0; rep < REP_MISC; ++rep) {
      float* tile = (float*)shm;
      if (even) {
        conv_matrix(P.a_w_in + (size_t)j * 1024 * 3264, 1024, 3264, 3328, Win, nullptr, tile);
        conv_matrix(P.mla_w_uq + (size_t)j * 384 * 768, 384, 768, 768, Wuq, P.mla_q_norm + j * 384, tile);
        conv_matrix(P.mla_w_ukv + (size_t)j * 256 * 1024, 256, 1024, 1024, Wukv, P.mla_kv_norm + j * 256, tile);
      } else {
        conv_matrix(P.c_w_in + (size_t)j * 1024 * 3072, 1024, 3072, 3072, Win, nullptr, tile);
      }
      conv_matrix(P.w_o + (size_t)l * 1024 * 1024, 1024, 1024, 1024, Wo, nullptr, tile);
      conv_matrix(P.mlp_w1 + (size_t)l * 1024 * 4096, 1024, 4096, 4096, W1, nullptr, tile);
      conv_matrix(P.mlp_w2 + (size_t)l * 4096 * 1024, 4096, 1024, 1024, W2, nullptr, tile);
      norm_phase(X, HB, P.norm_w + (size_t)(l * 2 + 0) * 1024, modL, modC, 0, 1024, PART, l > 0 ? 8 : 0, l == 0 ? P.x : nullptr, l == 0 ? P.ctx : nullptr);
    }
    GS();
    pg8::StaticOrder SO;
    if (even) {
      bf16_t* QH = (bf16_t*)(D + DE_QH); float* F = (float*)(D + DE_F); bf16_t* VH = (bf16_t*)(D + DE_VH); bf16_t* G = (bf16_t*)(D + DE_G); bf16_t* CQ = (bf16_t*)(D + DE_CQ);
      float* Sb = (float*)(D + DE_S); float* DLb = (float*)(D + DE_DL);
      bf16_t* U = (bf16_t*)(D + DE_U); bf16_t* Qa = (bf16_t*)(D + DE_QA); bf16_t* Ka = (bf16_t*)(D + DE_KA); bf16_t* Va = (bf16_t*)(D + DE_VA);
      { pg8::Gemm g{HB, Win, T_TOK, 3328, 1024, 1024, 1024}; SO.init(T_TOK, 3328, gridDim.x, blockIdx.x, 0);
        EpiG1Even E{QH, F, VH, G, CQ, LB + j * 1024}; for (int rep = 0; rep < REP_GEMM; ++rep) pg8::gemm_phase(glds, g, SO, E); }
      GS();
      hg_mfma_pass<1>(F, QH, VH, Sb, DLb, nullptr, shm);
      GS();
      rec_scan<128>(Sb, DLb, nullptr);
      GS();
      hg_mfma_pass<3>(F, QH, VH, Sb, DLb, HB, shm);
      GS();
      rec_combine(OFb, OBb, G, P.hg_norm + j * 128, Y, 0);
      { pg8::Gemm g{CQ, Wuq, T_TOK, 768, 384, 768, 384}; SO.init(T_TOK, 768, gridDim.x, blockIdx.x, 0);
        EpiBf16Off E{U, 1792, 0}; pg8::gemm_phase(glds, g, SO, E); }
      { pg8::Gemm g{CQ + 384, Wukv, T_TOK, 1024, 256, 768, 256}; SO.init(T_TOK, 1024, gridDim.x, blockIdx.x, 0);
        EpiBf16Off E{U, 1792, 768}; pg8::gemm_phase(glds, g, SO, E); }
      GS();
      mla_prep(U, CQ, Qa, Ka, Va, P.mla_qk_q + j * 192, P.mla_qk_k + j * 192, ROPE);
      GS();
      { const int nlat = 64 * 4, nit = nlat + (last ? 0 : 4); const float scale = 0.07216878364870322f;
        for (int rep = 0; rep < REP_ATT; ++rep)
        for (int it = blockIdx.x; it < nit; it += gridDim.x) {
          if (it < nlat) { const int qb = it >> 2, h = it & 3; const size_t r0 = NCTX + (size_t)qb * 256;
            attn_body<12, 1, false>(Qa + r0 * 768 + h * 192, 768, Ka + h * 192, 768, Va + h * 128, 512, Y + r0 * DM + 512 + h * 128, DM, T_TOK, scale, shm); }
          else { const int h = it - nlat;
            attn_body<12, 1, false>(Qa + h * 192, 768, Ka + h * 192, 768, Va + h * 128, 512, Y + 512 + h * 128, DM, NCTX, scale, shm); } } }
      GS();
    } else {
      bf16_t* DQK = (bf16_t*)(D + DO_DQK); bf16_t* DV = (bf16_t*)(D + DO_DV); float* RQ = (float*)(D + DO_RQ); float* RK = (float*)(D + DO_RK);
      bf16_t* RV = (bf16_t*)(D + DO_RV); bf16_t* RG = (bf16_t*)(D + DO_RG); bf16_t* OD = (bf16_t*)(D + DO_OD); float* Sb = (float*)(D + DO_S);
      const float* rtd = P.rt_decay + j * 8;
      { pg8::Gemm g{HB, Win, T_TOK, 3072, 1024, 1024, 1024}; SO.init(T_TOK, 3072, gridDim.x, blockIdx.x, 0);
        EpiG1Odd E{DQK, DV, RQ, RK, RV, RG, ROPE}; for (int rep = 0; rep < REP_GEMM; ++rep) pg8::gemm_phase(glds, g, SO, E); }
      GS();
      rt_mfma_pass<1>(RK, RQ, RV, Sb, nullptr, rtd, shm);
      diff_prep(DQK, P.da_qk_q + j * 64, P.da_qk_k + j * 64, ROPE);
      GS();
      rec_scan<64>(Sb, nullptr, rtd);
      { const int nlat = 64 * 8, nit = nlat + (last ? 0 : 8);
        for (int rep = 0; rep < REP_ATT; ++rep)
        for (int it = blockIdx.x; it < nit; it += gridDim.x) {
          if (it < nlat) { const int qb = it >> 3, hs = it & 7; const size_t r0 = NCTX + (size_t)qb * 256;
            attn_body<4, 2, true>(DQK + r0 * 1024 + hs * 64, 1024, DQK + 512 + hs * 64, 1024, DV + (hs >> 1) * 128, 512, OD + r0 * 1024 + hs * 128, 1024, T_TOK, 0.125f, shm); }
          else { const int hs = it - nlat;
            attn_body<4, 2, true>(DQK + hs * 64, 1024, DQK + 512 + hs * 64, 1024, DV + (hs >> 1) * 128, 512, OD + hs * 128, 1024, NCTX, 0.125f, shm); } } }
      GS();
      rt_mfma_pass<3>(RK, RQ, RV, Sb, HB, rtd, shm);
      GS();
      diff_combine(OD, P.da_subln + j * 128, SCAL[j * 2], SCAL[j * 2 + 1], Y);
      rec_combine(OFb, OBb, RG, P.rt_norm + j * 128, Y, 512);
      GS();
    }
    if (!last) { pg8::Gemm g{Y, Wo, T_TOK, 1024, 256, 1024, 1024}; pg8::SplitKOrder SK; SK.init(1024, 4, 256, gridDim.x, blockIdx.x);
      EpiPartial E{PART, modC + 2048, 256}; pg8::gemm_phase(glds, g, SK, E); }
    { pg8::Gemm g{Y, Wo, T_TOK, 1024, 1024, 1024, 1024}; SO.init(T_TOK, 1024, gridDim.x, blockIdx.x, 1);
      EpiResid E{X, modL + 2048, modC + 2048, nullptr, l == 0 ? P.x : nullptr}; pg8::gemm_phase(glds, g, SO, E);
      if (REP_GEMM > 1) { EpiBf16Off E2{(bf16_t*)D, 1024, 0}; pg8::gemm_phase(glds, g, SO, E2); } }
    GS();
    for (int rep = 0; rep < REP_MISC; ++rep)
    norm_phase(X, HB, P.norm_w + (size_t)(l * 2 + 1) * 1024, modL, modC, 3072, 4096, PART, last ? 0 : 4, nullptr, l == 0 ? P.ctx : nullptr);
    GS();
    bf16_t* Hid = (bf16_t*)D;
    { pg8::Gemm g{HB, W1, T_TOK, 4096, 1024, 1024, 1024}; SO.init(T_TOK, 4096, gridDim.x, blockIdx.x, pm0);
      EpiSqRelu E{Hid, 4096}; for (int rep = 0; rep < REP_GEMM; ++rep) pg8::gemm_phase(glds, g, SO, E); }
    GS();
    if (!last) { pg8::Gemm g{Hid, W2, T_TOK, 1024, 512, 4096, 4096}; pg8::SplitKOrder SK; SK.init(1024, 8, 512, gridDim.x, blockIdx.x);
      EpiPartial E{PART, modC + 5120, 512}; pg8::gemm_phase(glds, g, SK, E); }
    { pg8::Gemm g{Hid, W2, T_TOK, 1024, 4096, 4096, 4096}; SO.init(T_TOK, 1024, gridDim.x, blockIdx.x, 1);
      EpiResid E{X, modL + 5120, modC + 5120, last ? P.out : nullptr, nullptr}; pg8::gemm_phase(glds, g, SO, E);
      if (REP_GEMM > 1) { EpiBf16Off E2{HB, 1024, 0}; pg8::gemm_phase(glds, g, SO, E2); } }
    if (!last) GS();
  }
#undef GS
#undef P
#undef X
#undef HB
#undef Y
#undef W
#undef MOD
#undef ROPE
#undef LB
#undef SCAL
#undef BAR
#undef D
#undef PART
#undef Win
#undef Wo
#undef W1
#undef W2
#undef Wuq
#undef Wukv
#undef OFb
#undef OBb
#undef modL
#undef modC
#undef WS_
}

extern "C" void kernel_launch(void* const* d_in, const int* in_sizes, int n_in, void* d_out, int out_size, void* d_ws, size_t ws_size, hipStream_t stream) {
  constexpr size_t kDynLds = 131072;
  static int grid_blocks = 0;
  if (!grid_blocks) {
    hipFuncSetAttribute((const void*)fwd_megakernel, hipFuncAttributeMaxDynamicSharedMemorySize, (int)kDynLds);
    int dev = 0, cus = 0, per_cu = 0;
    hipGetDevice(&dev);
    hipDeviceGetAttribute(&cus, hipDeviceAttributeMultiprocessorCount, dev);
    hipOccupancyMaxActiveBlocksPerMultiprocessor(&per_cu, fwd_megakernel, 512, kDynLds);
    if (per_cu < 1) per_cu = 1;
    grid_blocks = cus * 1;
    if (ws_size < WS_NEED) fprintf(stderr, "workspace too small: %zu < %zu\n", ws_size, (size_t)WS_NEED);
  }
  Params p; memset(&p, 0, sizeof(p));
  const float* const* in = (const float* const*)d_in;
  p.x = in[0]; p.c = in[1]; p.ctx = in[2]; p.c_ctx = in[3]; p.ada_w = in[4]; p.ada_b = in[5]; p.norm_w = in[6]; p.w_o = in[7]; p.mlp_w1 = in[8]; p.mlp_w2 = in[9];
  p.a_w_in = in[10]; p.hg_lb = in[11]; p.hg_norm = in[12]; p.mla_q_norm = in[13]; p.mla_kv_norm = in[14]; p.mla_w_uq = in[15]; p.mla_w_ukv = in[16]; p.mla_qk_q = in[17]; p.mla_qk_k = in[18];
  p.c_w_in = in[19]; p.da_lambda = in[20]; p.da_qk_q = in[21]; p.da_qk_k = in[22]; p.da_subln = in[23]; p.rt_decay = in[24]; p.rt_norm = in[25];
  p.out = (float*)d_out; p.ws = (char*)d_ws;
  hipMemsetAsync((char*)d_ws + OFF_BAR, 0, 16384, stream);
  void* args[] = {&p};
  hipError_t e = hipLaunchCooperativeKernel((void*)fwd_megakernel, dim3(grid_blocks), dim3(512), args, kDynLds, stream);
  if (e != hipSuccess) fprintf(stderr, "cooperative launch failed: %s (grid %d)\n", hipGetErrorString(e), grid_blocks);
}
```
